# Optimizing an MI355X kernel written in HIP

```python
import math
import jax, jax.numpy as jnp
from jax import lax
import numpy as np

D_MODEL = 1024
BATCH = 1
SEQ = 16384
DEPTH = 4

HEAD_DIM = 64
HGRN_WIDTH = D_MODEL // 4
HGRN_HEADS = HGRN_WIDTH // HEAD_DIM
HGRN_CHUNK = 64
FOURIER_WIDTH = D_MODEL // 4
FOURIER_GROUPS = FOURIER_WIDTH // HEAD_DIM
ATTN_WIDTH = D_MODEL // 2
ATTN_HEADS = ATTN_WIDTH // HEAD_DIM
MIX_WIDTH = HGRN_WIDTH + FOURIER_WIDTH + ATTN_WIDTH
DILATED_PATTERNS = ((128, 1), (512, 4), (2048, 16))
ROPE_THETA = 10000.0
D_FF = 4 * D_MODEL
RMS_EPS = 1e-6
NEG_BIG = -1e30
IN_SPLITS = (HGRN_WIDTH, HGRN_WIDTH, HGRN_WIDTH, HGRN_WIDTH, HGRN_WIDTH, FOURIER_WIDTH, ATTN_WIDTH, ATTN_WIDTH, ATTN_WIDTH)
IN_WIDTH = sum(IN_SPLITS)
SPLIT_POINTS = [sum(IN_SPLITS[:i + 1]) for i in range(len(IN_SPLITS) - 1)]

kernel_name = "hybrid_hgrn2_fnet_dilated_attn_encoder"


def rms_norm(x, w):
    xf = x.astype(jnp.float32)
    y = xf * lax.rsqrt(jnp.mean(xf * xf, axis=-1, keepdims=True) + RMS_EPS)
    return (y * w.astype(jnp.float32)).astype(x.dtype)


def hgrn2_chunk_scan(q, k, v, log_f):
    B, H, S, dk = q.shape
    dv = v.shape[-1]
    C = HGRN_CHUNK
    n = S // C

    def chunked(t):
        return jnp.moveaxis(t.reshape(B, H, n, C, t.shape[-1]), 2, 0)

    tri = jnp.tril(jnp.ones((C, C), dtype=bool))[:, :, None]

    def step(state, inp):
        qc, kc, vc, gc = inp
        b = jnp.cumsum(gc, axis=-2)
        inter = jnp.einsum('bhtk,bhkv->bhtv', qc * jnp.exp(b), state)
        diff = b[..., :, None, :] - b[..., None, :, :]
        pair = jnp.where(tri, jnp.exp(jnp.where(tri, diff, 0.0)), 0.0)
        scores = jnp.einsum('bhtk,bhsk,bhtsk->bhts', qc, kc, pair)
        intra = jnp.einsum('bhts,bhsv->bhtv', scores, vc)
        b_last = b[..., -1:, :]
        new_state = (jnp.exp(b_last[..., 0, :])[..., None] * state
                     + jnp.einsum('bhsk,bhsv->bhkv', kc * jnp.exp(b_last - b), vc))
        return new_state, inter + intra

    init = jnp.zeros((B, H, dk, dv), dtype=jnp.float32)
    _, out = lax.scan(step, init, (chunked(q), chunked(k), chunked(v), chunked(log_f)))
    return jnp.moveaxis(out, 0, 2).reshape(B, H, S, dv)


def hgrn2_mixer(q_in, i_in, zf, zb, g_in, lb):
    B, S, W = q_in.shape
    H, dh = HGRN_HEADS, HEAD_DIM
    f32 = jnp.float32
    z = jnp.stack([zf, zb[:, ::-1]], axis=1).astype(f32)
    lbb = lb.astype(f32)[None, :, None, :]
    f = lbb + (1.0 - lbb) * jax.nn.sigmoid(z)
    log_f = jnp.log(f)
    k = 1.0 - f
    q = jax.nn.silu(q_in.astype(f32))
    v = i_in.astype(f32)
    q2 = jnp.stack([q, q[:, ::-1]], axis=1)
    v2 = jnp.stack([v, v[:, ::-1]], axis=1)

    def heads(t):
        return t.reshape(B, 2, S, H, dh).transpose(0, 1, 3, 2, 4).reshape(B, 2 * H, S, dh)

    o = hgrn2_chunk_scan(heads(q2), heads(k), heads(v2), heads(log_f)).reshape(B, 2, H, S, dh)
    o = o[:, 0] + o[:, 1][:, :, ::-1]
    o = o * lax.rsqrt(jnp.mean(o * o, axis=-1, keepdims=True) + RMS_EPS)
    o = o.transpose(0, 2, 1, 3).reshape(B, S, W)
    return o * jax.nn.silu(g_in.astype(f32))


def fourier_mixer(u):
    B, S, W = u.shape
    ug = u.astype(jnp.float32).reshape(B, S, FOURIER_GROUPS, W // FOURIER_GROUPS)
    y = jnp.fft.fft2(ug, axes=(1, 3), norm='ortho').real
    return y.reshape(B, S, W)


def rotary(t, positions):
    hd = t.shape[-1]
    inv_freq = ROPE_THETA ** (-jnp.arange(0, hd, 2, dtype=jnp.float32) / hd)
    ang = positions.astype(jnp.float32)[:, None, :, None] * inv_freq
    cos, sin = jnp.cos(ang), jnp.sin(ang)
    t1, t2 = t[..., :hd // 2], t[..., hd // 2:]
    return jnp.concatenate([t1 * cos - t2 * sin, t2 * cos + t1 * sin], axis=-1)


def dilated_window_attention(q, k, v, window, dilation):
    B, H, S, hd = q.shape
    d = dilation
    R = window // (2 * dilation)
    BLK = R
    L = S // d
    nb = -(-L // BLK)
    Lp = nb * BLK

    def sub(t):
        return t.reshape(B, H, L, d, hd).transpose(0, 1, 3, 2, 4)

    qs = jnp.pad(sub(q), ((0, 0), (0, 0), (0, 0), (0, Lp - L), (0, 0))).reshape(B, H, d, nb, BLK, hd)

    def key_blocks(t):
        tp = jnp.pad(sub(t), ((0, 0), (0, 0), (0, 0), (BLK, Lp - L + BLK), (0, 0))).reshape(B, H, d, nb + 2, BLK, hd)
        return jnp.concatenate([tp[:, :, :, :-2], tp[:, :, :, 1:-1], tp[:, :, :, 2:]], axis=-2)

    k3 = key_blocks(k)
    v3 = key_blocks(v)
    qj = jnp.arange(nb)[:, None, None] * BLK + jnp.arange(BLK)[None, :, None]
    kj = (jnp.arange(nb)[:, None, None] - 1) * BLK + jnp.arange(3 * BLK)[None, None, :]
    valid = (kj >= 0) & (kj < L) & (jnp.abs(qj - kj) <= R)
    s = jnp.einsum('bhrnqc,bhrnkc->bhrnqk', qs, k3)
    s = jnp.where(valid, s, NEG_BIG)
    lse = jax.nn.logsumexp(s, axis=-1)
    p = jnp.exp(s - lse[..., None])
    o = jnp.einsum('bhrnqk,bhrnkc->bhrnqc', p, v3)
    o = o.reshape(B, H, d, Lp, hd)[:, :, :, :L].transpose(0, 1, 3, 2, 4).reshape(B, H, S, hd)
    lse = lse.reshape(B, H, d, Lp)[..., :L].transpose(0, 1, 3, 2).reshape(B, H, S)
    return o, lse


def dilated_attention_mixer(cq, ck, cv, positions):
    B, S, W = cq.shape
    f32 = jnp.float32

    def heads(t):
        return t.astype(f32).reshape(B, S, ATTN_HEADS, HEAD_DIM).transpose(0, 2, 1, 3)

    q = rotary(heads(cq), positions) * (HEAD_DIM ** -0.5)
    k = rotary(heads(ck), positions)
    v = heads(cv)
    outs = []
    lses = []
    for window, dilation in DILATED_PATTERNS:
        o_p, lse_p = dilated_window_attention(q, k, v, window, dilation)
        outs.append(o_p)
        lses.append(lse_p)
    weights = jax.nn.softmax(jnp.stack(lses, axis=0), axis=0)
    o = jnp.sum(weights[..., None] * jnp.stack(outs, axis=0), axis=0)
    return o.transpose(0, 2, 1, 3).reshape(B, S, W)


def setup_inputs(seed: int = 0) -> dict:
    key = jax.random.key(seed)
    ks = jax.random.split(key, 10)
    f32 = jnp.float32
    x = jax.random.normal(ks[0], (BATCH, SEQ, D_MODEL), f32)
    positions = jnp.broadcast_to(jnp.arange(SEQ, dtype=jnp.int32)[None, :], (BATCH, SEQ))
    attn_norm_w = 1.0 + 0.02 * jax.random.normal(ks[1], (DEPTH, D_MODEL), f32)
    w_in = jax.random.normal(ks[2], (DEPTH, D_MODEL, IN_WIDTH), f32) * D_MODEL ** -0.5
    hgrn_lower_bounds = 0.5 * jax.random.normal(ks[3], (DEPTH, 2, HGRN_WIDTH), f32)
    w_out = jax.random.normal(ks[4], (DEPTH, MIX_WIDTH, D_MODEL), f32) * MIX_WIDTH ** -0.5
    mlp_norm_w = 1.0 + 0.02 * jax.random.normal(ks[5], (DEPTH, D_MODEL), f32)
    w_up = jax.random.normal(ks[6], (DEPTH, D_MODEL, D_FF), f32) * D_MODEL ** -0.5
    w_down = jax.random.normal(ks[7], (DEPTH, D_FF, D_MODEL), f32) * D_FF ** -0.5
    final_norm_w = 1.0 + 0.02 * jax.random.normal(ks[8], (D_MODEL,), f32)
    return {"x": x, "positions": positions, "attn_norm_w": attn_norm_w, "w_in": w_in,
            "hgrn_lower_bounds": hgrn_lower_bounds, "w_out": w_out, "mlp_norm_w": mlp_norm_w,
            "w_up": w_up, "w_down": w_down, "final_norm_w": final_norm_w}


def reference(x, positions, attn_norm_w, w_in, hgrn_lower_bounds, w_out, mlp_norm_w, w_up, w_down, final_norm_w):
    p_lb = jax.nn.softmax(hgrn_lower_bounds.astype(jnp.float32), axis=0)
    lb_all = jnp.cumsum(p_lb, axis=0) - p_lb[0:1]
    for layer in range(DEPTH):
        h = rms_norm(x, attn_norm_w[layer])
        proj = h @ w_in[layer]
        a_q, a_i, a_zf, a_zb, a_g, b_u, c_q, c_k, c_v = jnp.split(proj, SPLIT_POINTS, axis=-1)
        o_a = hgrn2_mixer(a_q, a_i, a_zf, a_zb, a_g, lb_all[layer]).astype(x.dtype)
        o_b = fourier_mixer(b_u).astype(x.dtype)
        o_c = dilated_attention_mixer(c_q, c_k, c_v, positions).astype(x.dtype)
        mixed = jnp.concatenate([o_a, o_b, o_c], axis=-1)
        x = x + mixed @ w_out[layer]
        h = rms_norm(x, mlp_norm_w[layer])
        x = x + jnp.square(jax.nn.relu(h @ w_up[layer])) @ w_down[layer]
    return rms_norm(x, final_norm_w)
```

```cpp
#include <hip/hip_runtime.h>
namespace pg8 {
#define PG8_LAS __attribute__((address_space(3)))
typedef unsigned short bf16_t;
typedef short bf16x8 __attribute__((ext_vector_type(8)));
typedef float f32x4 __attribute__((ext_vector_type(4)));
typedef unsigned u32x4 __attribute__((ext_vector_type(4)));
constexpr int BM = 256, BK = 64, HALF = 128, HTB = HALF * BK * 2  , STAGE_BYTES = 8 * HTB, NXCD = 8, WGM = 8;

__host__ __device__ __forceinline__ int lds_byte(int r, int c) { const int st = (r >> 4) * 2 + (c >> 5), rr = r & 15, cc = c & 31, ob = rr * 64 + cc * 2; return st * 1024 + (ob ^ (((ob >> 9) & 1) << 5)); }
__host__ __device__ __forceinline__ void stage_rc(int b, int& R, int& C) { const int st = b / 1024, sb = b % 1024, swz = sb ^ (((sb >> 9) & 1) << 5); R = (st >> 1) * 16 + swz / 64; C = (st & 1) * 32 + (swz % 64) / 2; }
__host__ __device__ __forceinline__ int perm32(int rho) { const int n = rho >> 4, i = rho & 15; return 8 * (i >> 2) + 4 * n + (i & 3); }

struct Unit { int pm, pn; };
struct Gemm { const bf16_t* A; const bf16_t* Bt; int M, N, K; };

struct StaticOrder {
    int nM, nN, nwg, G, c;
    __host__ __device__ void init(int M, int N, int G_, int c_) { nM = M / BM; nN = N / BM; nwg = nM * nN; G = G_; c = c_; }
    __host__ __device__ bool next(int i, Unit& u) const {
        const long L = (long)i * G + c; if (L >= nwg) return false;
        int wgid = (int)L; { const int q = nwg / NXCD, r = nwg % NXCD, xcd = wgid % NXCD, off = wgid / NXCD; wgid = (xcd < r ? xcd * (q + 1) : r * (q + 1) + (xcd - r) * q) + off; }
        const int nig = WGM * nN, gid = wgid / nig, fm = gid * WGM, gsz = (nM - fm) < WGM ? (nM - fm) : WGM;
        u.pm = fm + ((wgid % nig) % gsz); u.pn = (wgid % nig) / gsz; return true;
    }
    __device__ __forceinline__ void a_ready(const Unit&) const {}
    __device__ __forceinline__ void done(const Unit&) const {}
};
__device__ __forceinline__ unsigned cvt_pk_bf16(float lo, float hi) { unsigned r; asm volatile("v_cvt_pk_bf16_f32 %0, %1, %2" : "=v"(r) : "v"(lo), "v"(hi)); return r; }
typedef float f32x2 __attribute__((ext_vector_type(2)));
template <class Epi, class Sched, bool STAMP = false>
__device__ __forceinline__ void gemm_phase(PG8_LAS unsigned char* lds, const Gemm g, const Sched& S, const Epi& E, unsigned long long* stamps) {
    int tid_l = threadIdx.x; asm volatile("" : "+v"(tid_l)); const int tid = tid_l, wid = __builtin_amdgcn_readfirstlane(tid >> 6), lane = tid & 63, wr = wid >> 2, wc = wid & 3, fr = lane & 15, fq = lane >> 4;
    const int K = g.K, nt = K / BK;
    int ts_lo = 0, ts_hi = 0, nts = 0; const unsigned long long rt_entry = STAMP ? (unsigned long long)wall_clock64() : 0ull;
#define PG8_STAMP() do { if (STAMP && wid == 0 && nts < 64) { const unsigned long long _c = (unsigned long long)clock64(); \
        ts_lo = (lane == nts) ? (int)(unsigned)_c : ts_lo; ts_hi = (lane == nts) ? (int)(unsigned)(_c >> 32) : ts_hi; ++nts; } } while (0)
    PG8_STAMP();
    unsigned voffA[2], voffB[2];
#pragma unroll
    for (int i = 0; i < 2; ++i) { int R, C; stage_rc(tid * 16 + i * 8192, R, C); const int Rb = Epi::PERM ? ((R & ~31) + perm32(R & 31)) : R;
        voffA[i] = (unsigned)(R * K + C) * 2u; voffB[i] = (unsigned)(Rb * K + C) * 2u; }
    const size_t kstep = (size_t)(BK * 2);
    const size_t hstep = (size_t)HALF * K * 2;
    const size_t tstep = 2 * hstep;
    const unsigned ldsw = (unsigned)wid * 1024u;
    const int aoff = lds_byte(wr * 64 + fr, fq * 8), boff = lds_byte(wc * 32 + fr, fq * 8);
#define PG8_SA(b, h) (((b) * 2 + (h)) * HTB)
#define PG8_SB(b, h) ((4 + (b) * 2 + (h)) * HTB)
#define PG8_STAGE(bufoff, gbase, voff) do { _Pragma("unroll") for (int _i = 0; _i < 2; ++_i) \
        __builtin_amdgcn_global_load_lds((const unsigned*)((const char*)(gbase) + (voff)[_i]), (PG8_LAS unsigned*)(lds + (bufoff) + ldsw + _i * 8192), 16, 0, 0); } while (0)
#define PG8_LDA(dst, b, h) do { _Pragma("unroll") for (int m = 0; m < 4; ++m) _Pragma("unroll") for (int k = 0; k < 2; ++k) dst[m][k] = *(const PG8_LAS bf16x8*)(lds + PG8_SA(b, h) + aoff + m * 2048 + k * 1024); } while (0)
#define PG8_LDB(dst, b, h) do { _Pragma("unroll") for (int n = 0; n < 2; ++n) _Pragma("unroll") for (int k = 0; k < 2; ++k) dst[n][k] = *(const PG8_LAS bf16x8*)(lds + PG8_SB(b, h) + boff + n * 2048 + k * 1024); } while (0)
#define PG8_MMA(ai, bj, At, Bt) do { __builtin_amdgcn_s_setprio(1); _Pragma("unroll") for (int m = 0; m < 4; ++m) _Pragma("unroll") for (int n = 0; n < 2; ++n) _Pragma("unroll") for (int k = 0; k < 2; ++k) \
        acc[ai][bj][m][n] = __builtin_amdgcn_mfma_f32_16x16x32_bf16(Bt[n][k], At[m][k], acc[ai][bj][m][n], 0, 0, 0); __builtin_amdgcn_s_setprio(0); } while (0)
#define PG8_WAIT_V(n) asm volatile("s_waitcnt vmcnt(" #n ")" ::: "memory")
#define PG8_WAIT_L(n) asm volatile("s_waitcnt lgkmcnt(" #n ")" ::: "memory")
#define PG8_BAR __builtin_amdgcn_s_barrier()
#define PG8_SCHED __builtin_amdgcn_sched_barrier(0)
    Unit cur, nxt; int ui = 0;
    if (!S.next(0, cur)) return;
    f32x4 acc[2][2][4][2];
#pragma unroll
    for (int a = 0; a < 2; ++a)
#pragma unroll
        for (int b = 0; b < 2; ++b)
#pragma unroll
            for (int m = 0; m < 4; ++m)
#pragma unroll
                for (int n = 0; n < 2; ++n) acc[a][b][m][n] = (f32x4){0.f, 0.f, 0.f, 0.f};
    bf16x8 At[4][2], B0[2][2], B1[2][2];
    const char* cA = (const char*)g.A + (size_t)cur.pm * tstep; const char* cB = (const char*)g.Bt + (size_t)cur.pn * tstep;
    S.a_ready(cur);
    PG8_STAGE(PG8_SB(0, 0), cB, voffB); PG8_STAGE(PG8_SA(0, 0), cA, voffA); PG8_STAGE(PG8_SB(0, 1), cB + hstep, voffB); PG8_STAGE(PG8_SA(0, 1), cA + hstep, voffA);
    if (wr == 1) PG8_BAR;
    PG8_WAIT_V(4); PG8_BAR;
    PG8_STAGE(PG8_SB(1, 0), cB + kstep, voffB); PG8_STAGE(PG8_SA(1, 0), cA + kstep, voffA); PG8_STAGE(PG8_SB(1, 1), cB + hstep + kstep, voffB);
    PG8_WAIT_V(6); PG8_BAR;
    PG8_STAMP();
    for (;;) {
        const bool has_next = S.next(ui + 1, nxt);
        const char* nA = has_next ? (const char*)g.A + (size_t)nxt.pm * tstep : cA; const char* nB = has_next ? (const char*)g.Bt + (size_t)nxt.pn * tstep : cB;
        for (int t = 0; t < nt; t += 2) {
            const bool last = (t == nt - 2);
            const char* a1 = cA + (size_t)(t + 1) * kstep;
            const char* a2 = last ? nA : cA + (size_t)(t + 2) * kstep; const char* b2 = last ? nB : cB + (size_t)(t + 2) * kstep;
            const char* a3 = a2 + kstep; const char* b3 = b2 + kstep;
            if (last && has_next) S.a_ready(nxt);
            PG8_LDB(B0, 0, 0); PG8_SCHED; PG8_LDA(At, 0, 0); PG8_STAGE(PG8_SA(1, 1), a1 + hstep, voffA);
            PG8_WAIT_L(8); PG8_BAR; PG8_WAIT_L(0); PG8_MMA(0, 0, At, B0); PG8_BAR; PG8_SCHED;
            PG8_LDB(B1, 0, 1); PG8_STAGE(PG8_SB(0, 0), b2, voffB);
            PG8_BAR; PG8_WAIT_L(0); PG8_MMA(0, 1, At, B1); PG8_BAR;
            PG8_LDA(At, 0, 1); PG8_STAGE(PG8_SA(0, 0), a2, voffA);
            PG8_BAR; PG8_WAIT_L(0); PG8_MMA(1, 0, At, B0); PG8_BAR; PG8_SCHED;
            PG8_STAGE(PG8_SB(0, 1), b2 + hstep, voffB);
            PG8_WAIT_V(6); PG8_BAR; PG8_MMA(1, 1, At, B1); PG8_BAR;
            PG8_LDB(B0, 1, 0); PG8_SCHED; PG8_LDA(At, 1, 0); PG8_STAGE(PG8_SA(0, 1), a2 + hstep, voffA);
            PG8_WAIT_L(8); PG8_BAR; PG8_WAIT_L(0); PG8_MMA(0, 0, At, B0); PG8_BAR; PG8_SCHED;
            PG8_LDB(B1, 1, 1); PG8_STAGE(PG8_SB(1, 0), b3, voffB);
            PG8_BAR; PG8_WAIT_L(0); PG8_MMA(0, 1, At, B1); PG8_BAR;
            PG8_LDA(At, 1, 1); PG8_STAGE(PG8_SA(1, 0), a3, voffA);
            PG8_BAR; PG8_WAIT_L(0); PG8_MMA(1, 0, At, B0); PG8_BAR; PG8_SCHED;
            PG8_STAGE(PG8_SB(1, 1), b3 + hstep, voffB);
            PG8_WAIT_V(6); PG8_BAR; PG8_MMA(1, 1, At, B1); PG8_BAR;
        }
        PG8_STAMP();
        if constexpr (!Epi::AFTER_DRAIN) { E(acc, cur, wr, wc, fr, fq); S.done(cur); }
        PG8_STAMP();
        if (!has_next) break;
#pragma unroll
        for (int a = 0; a < 2; ++a)
#pragma unroll
            for (int b = 0; b < 2; ++b)
#pragma unroll
                for (int m = 0; m < 4; ++m)
#pragma unroll
                    for (int n = 0; n < 2; ++n) acc[a][b][m][n] = (f32x4){0.f, 0.f, 0.f, 0.f};
        cur = nxt; cA = nA; cB = nB; ++ui;
    }
    PG8_WAIT_V(0);
    if (wr == 0) PG8_BAR;
    PG8_BAR;
    if constexpr (Epi::AFTER_DRAIN) { E.fused(acc, cur, wr, wc, fr, fq, lds, wid, lane); S.done(cur); }
    PG8_STAMP();
    if (STAMP && wid == 0) { stamps[lane] = lane < nts ? (((unsigned long long)(unsigned)ts_hi << 32) | (unsigned)ts_lo) : 0ull;
        if (lane == 62) stamps[62] = rt_entry; if (lane == 63) stamps[63] = (unsigned long long)wall_clock64(); }
#undef PG8_STAMP
#undef PG8_SA
#undef PG8_SB
#undef PG8_STAGE
#undef PG8_LDA
#undef PG8_LDB
#undef PG8_MMA
#undef PG8_WAIT_V
#undef PG8_WAIT_L
#undef PG8_BAR
#undef PG8_SCHED
}
}

#include <hip/hip_cooperative_groups.h>
#include <cstdio>
namespace cg = cooperative_groups;
namespace mk {
using pg8::bf16_t; using pg8::bf16x8; using pg8::f32x4; using pg8::u32x4; using pg8::cvt_pk_bf16; using pg8::Unit;
#define LAS __attribute__((address_space(3)))
typedef unsigned u32x2 __attribute__((ext_vector_type(2)));
typedef float f32x2 __attribute__((ext_vector_type(2)));

constexpr int S = 16384, D = 1024, NIN = 3072, FF = 4096, DEPTH = 4;
constexpr int NTHR = 512;
constexpr int LDS_BYTES = 151552;
constexpr size_t MiB = (size_t)1 << 20;
constexpr size_t OFF_LB = 0, OFF_W128C = 16384, OFF_W128S = 49152, OFF_C64 = 81920, OFF_S64 = 90112, OFF_TW = 131072, OFF_CS = 1 * MiB;
constexpr size_t WS_W = 8 * MiB, W_IN = WS_W, W_OUT = WS_W + 6 * MiB, W_UP = WS_W + 8 * MiB, W_DOWN = WS_W + 16 * MiB;
constexpr size_t WS_XN = 32 * MiB, WS_UT = 32 * MiB;
constexpr size_t WS_HQ = 64 * MiB, WS_HV = 72 * MiB, WS_HG = 80 * MiB, WS_FU = 88 * MiB, WS_LF = 96 * MiB;
constexpr size_t WS_AQ = 128 * MiB, WS_AK = 144 * MiB, WS_MIXED = 128 * MiB, WS_AV = 160 * MiB, WS_SS = 160 * MiB;
constexpr size_t WS_OP = 176 * MiB, WS_TP = 224 * MiB, WS_DEC = 240 * MiB, WS_LSE = 241 * MiB;
constexpr size_t WS_H = 64 * MiB;

struct P { const float* x; const int* pos; const float* anw; const float* w_in; const float* lbs; const float* w_out; const float* mnw;
           const float* w_up; const float* w_down; const float* fnw; float* out; unsigned char* ws; int ph_lo, ph_hi; };
struct Ctx { LAS unsigned char* lds; int tid, lane, wave, bid, G; };

__device__ __forceinline__ float bf2f(unsigned short b) { return __uint_as_float(((unsigned)b) << 16); }
__device__ __forceinline__ unsigned short f2bf(float f) { return (unsigned short)(cvt_pk_bf16(f, 0.f) & 0xffffu); }
__device__ __forceinline__ f32x4 mfma16(bf16x8 a, bf16x8 b, f32x4 c) { return __builtin_amdgcn_mfma_f32_16x16x32_bf16(a, b, c, 0, 0, 0); }
__device__ __forceinline__ float wave_sum(float v) {
#pragma unroll
    for (int o = 1; o < 64; o <<= 1) v += __shfl_xor(v, o);
    return v;
}
__device__ __forceinline__ float silu(float v) { return v / (1.f + __expf(-v)); }
#define LDS_WAIT() asm volatile("s_waitcnt lgkmcnt(0)" ::: "memory")

struct EpiRes {
    static constexpr bool PERM = false, AFTER_DRAIN = false;
    const float* base; float* out; int ldc;
    __device__ __forceinline__ void operator()(const f32x4 (&acc)[2][2][4][2], const Unit& u, int wr, int wc, int fr, int fq) const {
        const int row0 = u.pm * 256 + wr * 64 + fr, col0 = u.pn * 256 + wc * 32 + 4 * fq;
#pragma unroll
        for (int ai = 0; ai < 2; ++ai)
#pragma unroll
            for (int m = 0; m < 4; ++m) { const size_t off = (size_t)(row0 + ai * 128 + m * 16) * ldc + col0;
#pragma unroll
                for (int bj = 0; bj < 2; ++bj)
#pragma unroll
                    for (int n = 0; n < 2; ++n) { const f32x4 b = *(const f32x4*)(base + off + bj * 128 + n * 16); *(f32x4*)(out + off + bj * 128 + n * 16) = b + acc[ai][bj][m][n]; }
                asm volatile("" ::: "memory"); }
    }
};
struct EpiUp {
    static constexpr bool PERM = true, AFTER_DRAIN = false;
    bf16_t* O; int ldc;
    __device__ __forceinline__ void operator()(const f32x4 (&acc)[2][2][4][2], const Unit& u, int wr, int wc, int fr, int fq) const {
        const int row0 = u.pm * 256 + wr * 64 + fr, col0 = u.pn * 256 + wc * 32 + 8 * fq;
#pragma unroll
        for (int ai = 0; ai < 2; ++ai)
#pragma unroll
            for (int m = 0; m < 4; ++m) { bf16_t* rowp = O + (size_t)(row0 + ai * 128 + m * 16) * ldc + col0;
#pragma unroll
                for (int bj = 0; bj < 2; ++bj) { f32x4 v0 = acc[ai][bj][m][0], v1 = acc[ai][bj][m][1];
#pragma unroll
                    for (int e = 0; e < 4; ++e) { float a = fmaxf(v0[e], 0.f), b = fmaxf(v1[e], 0.f); v0[e] = a * a; v1[e] = b * b; }
                    u32x4 w; w.x = cvt_pk_bf16(v0[0], v0[1]); w.y = cvt_pk_bf16(v0[2], v0[3]); w.z = cvt_pk_bf16(v1[0], v1[1]); w.w = cvt_pk_bf16(v1[2], v1[3]);
                    *(u32x4*)(rowp + bj * 128) = w; } }
    }
};
struct EpiIn {
    static constexpr bool PERM = true, AFTER_DRAIN = false;
    bf16_t *HQ, *HV, *HG, *FU, *AQ, *AK, *AV; float* LF; const float* LB; const float* CS;
    __device__ __forceinline__ void operator()(const f32x4 (&acc)[2][2][4][2], const Unit& u, int wr, int wc, int fr, int fq) const {
        const int pn = u.pn; const int row0 = u.pm * 256 + wr * 64 + fr; const int c8 = wc * 32 + 8 * fq;
        if (pn >= 6 && pn <= 9) {
            const bool isq = pn < 8; bf16_t* dst = isq ? AQ : AK; const int headg = (pn - (isq ? 6 : 8)) * 4 + wc; const float sc = isq ? 0.125f : 1.f; const int i0 = 8 * fq;
#pragma unroll
            for (int ai = 0; ai < 2; ++ai)
#pragma unroll
                for (int m = 0; m < 4; ++m) { const int row = row0 + ai * 128 + m * 16;
                    const f32x4* cs = (const f32x4*)(CS + ((size_t)row * 32 + i0) * 2);
                    float o1[8], o2[8];
#pragma unroll
                    for (int n = 0; n < 2; ++n)
#pragma unroll
                        for (int e2 = 0; e2 < 2; ++e2) { const f32x4 t = cs[n * 2 + e2];
                            { const int e = 2 * e2; const float x1 = acc[ai][0][m][n][e], x2 = acc[ai][1][m][n][e]; o1[4 * n + e] = (x1 * t[0] - x2 * t[1]) * sc; o2[4 * n + e] = (x2 * t[0] + x1 * t[1]) * sc; }
                            { const int e = 2 * e2 + 1; const float x1 = acc[ai][0][m][n][e], x2 = acc[ai][1][m][n][e]; o1[4 * n + e] = (x1 * t[2] - x2 * t[3]) * sc; o2[4 * n + e] = (x2 * t[2] + x1 * t[3]) * sc; } }
                    u32x4 w1, w2; w1.x = cvt_pk_bf16(o1[0], o1[1]); w1.y = cvt_pk_bf16(o1[2], o1[3]); w1.z = cvt_pk_bf16(o1[4], o1[5]); w1.w = cvt_pk_bf16(o1[6], o1[7]);
                    w2.x = cvt_pk_bf16(o2[0], o2[1]); w2.y = cvt_pk_bf16(o2[2], o2[3]); w2.z = cvt_pk_bf16(o2[4], o2[5]); w2.w = cvt_pk_bf16(o2[6], o2[7]);
                    bf16_t* rp = dst + (size_t)row * 512 + headg * 64 + i0;
                    *(u32x4*)rp = w1; *(u32x4*)(rp + 32) = w2; asm volatile("" ::: "memory"); }
        } else if (pn == 2 || pn == 3) {
            const int dir = pn - 2;
#pragma unroll
            for (int bj = 0; bj < 2; ++bj) { const int col = bj * 128 + c8; const f32x4 l0 = *(const f32x4*)(LB + dir * 256 + col), l1 = *(const f32x4*)(LB + dir * 256 + col + 4);
#pragma unroll
                for (int ai = 0; ai < 2; ++ai)
#pragma unroll
                    for (int m = 0; m < 4; ++m) { const int row = row0 + ai * 128 + m * 16; f32x4 r0, r1;
#pragma unroll
                        for (int e = 0; e < 4; ++e) { const float s0 = 1.f / (1.f + __expf(-acc[ai][bj][m][0][e])), s1 = 1.f / (1.f + __expf(-acc[ai][bj][m][1][e]));
                            r0[e] = logf(l0[e] + (1.f - l0[e]) * s0); r1[e] = logf(l1[e] + (1.f - l1[e]) * s1); }
                        float* rp = LF + ((size_t)dir * S + row) * 256 + col; *(f32x4*)rp = r0; *(f32x4*)(rp + 4) = r1; asm volatile("" ::: "memory"); } }
        } else {
            bf16_t* dst; int ld, cb; bool act = false;
            if (pn == 0) { dst = HQ; ld = 256; cb = 0; act = true; } else if (pn == 1) { dst = HV; ld = 256; cb = 0; } else if (pn == 4) { dst = HG; ld = 256; cb = 0; act = true; }
            else if (pn == 5) { dst = FU; ld = 256; cb = 0; } else { dst = AV; ld = 512; cb = (pn - 10) * 256; }
#pragma unroll
            for (int ai = 0; ai < 2; ++ai)
#pragma unroll
                for (int m = 0; m < 4; ++m) { bf16_t* rowp = dst + (size_t)(row0 + ai * 128 + m * 16) * ld + cb + c8;
#pragma unroll
                    for (int bj = 0; bj < 2; ++bj) { f32x4 v0 = acc[ai][bj][m][0], v1 = acc[ai][bj][m][1];
                        if (act) {
#pragma unroll
                            for (int e = 0; e < 4; ++e) { v0[e] = silu(v0[e]); v1[e] = silu(v1[e]); } }
                        u32x4 w; w.x = cvt_pk_bf16(v0[0], v0[1]); w.y = cvt_pk_bf16(v0[2], v0[3]); w.z = cvt_pk_bf16(v1[0], v1[1]); w.w = cvt_pk_bf16(v1[2], v1[3]);
                        *(u32x4*)(rowp + bj * 128) = w; } }
        }
    }
};

__device__ __forceinline__ void make_tables(const Ctx& c, const P& p) {
    unsigned char* ws = p.ws;
    const int gt = c.bid * NTHR + c.tid, gs = c.G * NTHR;
    float* LB = (float*)(ws + OFF_LB);
    for (int e = gt; e < 512; e += gs) {
        float v[DEPTH], mx = -1e30f; for (int l = 0; l < DEPTH; ++l) { v[l] = p.lbs[l * 512 + e]; mx = fmaxf(mx, v[l]); }
        float sum = 0.f; for (int l = 0; l < DEPTH; ++l) { v[l] = expf(v[l] - mx); sum += v[l]; }
        float cum = 0.f; LB[e] = 0.f; for (int l = 1; l < DEPTH; ++l) { cum += v[l] / sum; LB[l * 512 + e] = cum; }
    }
    bf16_t* WC = (bf16_t*)(ws + OFF_W128C); bf16_t* WS_ = (bf16_t*)(ws + OFF_W128S);
    for (int e = gt; e < 16384; e += gs) { const int a = e >> 7, b = e & 127, idx = (a * b) & 127; const float x = (float)idx * (1.f / 64.f); WC[e] = f2bf(cospif(x)); WS_[e] = f2bf(sinpif(x)); }
    bf16_t* C64 = (bf16_t*)(ws + OFF_C64); bf16_t* S64 = (bf16_t*)(ws + OFF_S64);
    for (int e = gt; e < 4096; e += gs) { const int a = e >> 6, b = e & 63, idx = (a * b) & 63; const float x = (float)idx * (1.f / 32.f); C64[e] = f2bf(cospif(x)); S64[e] = f2bf(sinpif(x)); }
    float* TW = (float*)(ws + OFF_TW);
    for (int e = gt; e < 16384; e += gs) { const int a = e >> 7, b = e & 127, idx = a * b; const float x = (float)idx * (1.f / 8192.f); TW[2 * e] = cospif(x); TW[2 * e + 1] = sinpif(x); }
    float* CS = (float*)(ws + OFF_CS);
    for (int e = gt; e < S * 32; e += gs) { const int s = e >> 5, i = e & 31; const float invf = powf(10000.f, -(float)(2 * i) / 64.f); const float ang = (float)p.pos[s] * invf;
        double xr = (double)ang * 0.31830988618379067154; xr = xr - 2.0 * rint(xr * 0.5); const float xf = (float)xr; CS[2 * e] = cospif(xf); CS[2 * e + 1] = sinpif(xf); }
}
__device__ __forceinline__ void transpose_item(const float* W, int K, int N, bf16_t* WT, int k0, int n0, int drow0, LAS float* scr, int lane) {
#pragma unroll 8
    for (int i = 0; i < 32; ++i) { const int kk = 2 * i + (lane >> 5); scr[kk * 33 + (lane & 31)] = W[(size_t)(k0 + kk) * N + n0 + (lane & 31)]; }
    LDS_WAIT();
    const int cc = lane & 7;
#pragma unroll
    for (int j = 0; j < 4; ++j) { const int n = (lane >> 3) + 8 * j; const LAS float* s = scr + (8 * cc) * 33 + n;
        u32x4 o; o.x = cvt_pk_bf16(s[0 * 33], s[1 * 33]); o.y = cvt_pk_bf16(s[2 * 33], s[3 * 33]); o.z = cvt_pk_bf16(s[4 * 33], s[5 * 33]); o.w = cvt_pk_bf16(s[6 * 33], s[7 * 33]);
        *(u32x4*)(WT + (size_t)(drow0 + n) * K + k0 + 8 * cc) = o; }
    LDS_WAIT();
}
__device__ __forceinline__ void convert_weights(const Ctx& c, const P& p, int layer) {
    LAS float* scr = (LAS float*)(c.lds + c.wave * 16384);
    const int gw = c.bid * 8 + c.wave, NGW = c.G * 8;
    const float* win = p.w_in + (size_t)layer * D * NIN; const float* wout = p.w_out + (size_t)layer * D * D;
    const float* wup = p.w_up + (size_t)layer * D * FF; const float* wdn = p.w_down + (size_t)layer * FF * D;
    bf16_t* tin = (bf16_t*)(p.ws + W_IN); bf16_t* tout = (bf16_t*)(p.ws + W_OUT); bf16_t* tup = (bf16_t*)(p.ws + W_UP); bf16_t* tdn = (bf16_t*)(p.ws + W_DOWN);
    constexpr int I_IN = 16 * 96, I_OUT = 16 * 32, I_UP = 16 * 128, I_DN = 64 * 32;
    for (int it = gw; it < I_IN + I_OUT + I_UP + I_DN; it += NGW) {
        int r = it;
        if (r < I_IN) { const int kb = r / 96, nb = r % 96; const int pn = nb >> 3; int drow = nb * 32;
            if (pn >= 6 && pn <= 9) { const int sb = nb & 7, head = sb >> 1, half = sb & 1; drow = pn * 256 + (4 * half + head) * 32; }
            transpose_item(win, D, NIN, tin, kb * 64, nb * 32, drow, scr, c.lane); continue; }
        r -= I_IN;
        if (r < I_OUT) { const int kb = r / 32, nb = r % 32; transpose_item(wout, D, D, tout, kb * 64, nb * 32, nb * 32, scr, c.lane); continue; }
        r -= I_OUT;
        if (r < I_UP) { const int kb = r / 128, nb = r % 128; transpose_item(wup, D, FF, tup, kb * 64, nb * 32, nb * 32, scr, c.lane); continue; }
        r -= I_UP;
        { const int kb = r / 32, nb = r % 32; transpose_item(wdn, FF, D, tdn, kb * 64, nb * 32, nb * 32, scr, c.lane); }
    }
}
__device__ __forceinline__ void norm_rows(const Ctx& c, const float* src, const float* w, bf16_t* dst_bf, float* dst_f) {
    const int gw = c.bid * 8 + c.wave, NGW = c.G * 8, lane = c.lane;
    f32x4 w4[4];
#pragma unroll
    for (int j = 0; j < 4; ++j) w4[j] = ((const f32x4*)w)[lane + 64 * j];
    for (int m = gw; m < S; m += NGW) {
        const f32x4* xr = (const f32x4*)(src + (size_t)m * D) + lane; f32x4 v[4]; float s = 0.f;
#pragma unroll
        for (int j = 0; j < 4; ++j) { v[j] = xr[64 * j]; s += (v[j][0] * v[j][0] + v[j][1] * v[j][1]) + (v[j][2] * v[j][2] + v[j][3] * v[j][3]); }
        const float rs = 1.f / sqrtf(wave_sum(s) * (1.f / D) + 1e-6f);
        if (dst_bf) { u32x2* o = (u32x2*)(dst_bf + (size_t)m * D) + lane;
#pragma unroll
            for (int j = 0; j < 4; ++j) { u32x2 q; q.x = cvt_pk_bf16(v[j][0] * rs * w4[j][0], v[j][1] * rs * w4[j][1]); q.y = cvt_pk_bf16(v[j][2] * rs * w4[j][2], v[j][3] * rs * w4[j][3]); o[64 * j] = q; } }
        else { f32x4* o = (f32x4*)(dst_f + (size_t)m * D) + lane;
#pragma unroll
            for (int j = 0; j < 4; ++j) o[64 * j] = v[j] * rs * w4[j]; }
    }
}

__device__ __forceinline__ void hgrn_passA(const Ctx& c, const float* LF, const bf16_t* HV, float* UT, float* DEC) {
    const int h = c.wave >> 1, dir = c.wave & 1, lane = c.lane, fr = lane & 15, fq = lane >> 4;
    LAS bf16_t* KlT = (LAS bf16_t*)(c.lds + c.wave * 9216);
    LAS bf16_t* VT = (LAS bf16_t*)(c.lds + 8 * 9216 + h * 9216);
    for (int n = c.bid; n < 256; n += c.G) {
        const float* lfp = LF + ((size_t)dir * S + n * 64) * 256 + h * 64 + lane;
        float lf[64];
#pragma unroll
        for (int t = 0; t < 64; ++t) { lf[t] = lfp[(size_t)t * 256]; if ((t & 15) == 15) asm volatile("" ::: "memory"); }
        float run = 0.f;
        if (dir == 0) {
#pragma unroll
            for (int s = 63; s >= 0; --s) { const float l = lf[s]; lf[s] = (1.f - __expf(l)) * __expf(run); run += l; }
        } else {
#pragma unroll
            for (int s = 0; s < 64; ++s) { const float l = lf[s]; lf[s] = (1.f - __expf(l)) * __expf(run); run += l; }
        }
#pragma unroll
        for (int i = 0; i < 8; ++i) { u32x4 w; w.x = cvt_pk_bf16(lf[8 * i], lf[8 * i + 1]); w.y = cvt_pk_bf16(lf[8 * i + 2], lf[8 * i + 3]); w.z = cvt_pk_bf16(lf[8 * i + 4], lf[8 * i + 5]); w.w = cvt_pk_bf16(lf[8 * i + 6], lf[8 * i + 7]);
            *(LAS u32x4*)(KlT + lane * 72 + 8 * i) = w; }
        DEC[((size_t)(n * 2 + dir) * 4 + h) * 64 + lane] = __expf(run);
        asm volatile("" ::: "memory");
        if (dir == 0) {
            const bf16_t* vp = HV + (size_t)(n * 64) * 256 + h * 64 + lane;
            unsigned vv[64];
#pragma unroll
            for (int t = 0; t < 64; ++t) { vv[t] = vp[(size_t)t * 256]; if ((t & 15) == 15) asm volatile("" ::: "memory"); }
#pragma unroll
            for (int i = 0; i < 8; ++i) { u32x4 w; w.x = vv[8 * i] | (vv[8 * i + 1] << 16); w.y = vv[8 * i + 2] | (vv[8 * i + 3] << 16); w.z = vv[8 * i + 4] | (vv[8 * i + 5] << 16); w.w = vv[8 * i + 6] | (vv[8 * i + 7] << 16);
                *(LAS u32x4*)(VT + lane * 72 + 8 * i) = w; }
        }
        __syncthreads();
        f32x4 acc[4][4];
#pragma unroll
        for (int a = 0; a < 4; ++a)
#pragma unroll
            for (int b = 0; b < 4; ++b) acc[a][b] = (f32x4){0.f, 0.f, 0.f, 0.f};
#pragma unroll
        for (int kk = 0; kk < 2; ++kk) { bf16x8 a[4], b[4];
#pragma unroll
            for (int t = 0; t < 4; ++t) { a[t] = *(const LAS bf16x8*)(VT + (16 * t + fr) * 72 + 32 * kk + 8 * fq); b[t] = *(const LAS bf16x8*)(KlT + (16 * t + fr) * 72 + 32 * kk + 8 * fq); }
#pragma unroll
            for (int mt = 0; mt < 4; ++mt)
#pragma unroll
                for (int nt = 0; nt < 4; ++nt) acc[mt][nt] = mfma16(a[mt], b[nt], acc[mt][nt]); }
        int lo_ = (4 * fq) * 64 + fr; asm volatile("" : "+v"(lo_));
        float* up = UT + ((size_t)(n * 2 + dir) * 4 + h) * 4096 + lo_;
#pragma unroll
        for (int mt = 0; mt < 4; ++mt)
#pragma unroll
            for (int nt = 0; nt < 4; ++nt)
#pragma unroll
                for (int j = 0; j < 4; ++j) up[(16 * mt + j) * 64 + 16 * nt] = acc[mt][nt][j];
        __syncthreads();
    }
}
__device__ __forceinline__ void hgrn_scan(int e, const float* UT, const float* DEC, bf16_t* SS) {
    const int dir = e >> 14, hk = e & 16383, h = hk >> 12, k = e & 63;
    float st = 0.f;
    for (int n0 = 0; n0 < 256; n0 += 8) {
        float u[8], d[8];
#pragma unroll
        for (int i = 0; i < 8; ++i) { const int n = dir ? (255 - n0 - i) : (n0 + i); u[i] = UT[(size_t)(n * 2 + dir) * 16384 + hk]; d[i] = DEC[((size_t)(n * 2 + dir) * 4 + h) * 64 + k]; }
#pragma unroll
        for (int i = 0; i < 8; ++i) { const int n = dir ? (255 - n0 - i) : (n0 + i); SS[(size_t)(n * 2 + dir) * 16384 + hk] = f2bf(st); st = d[i] * st + u[i]; }
    }
}
__device__ __forceinline__ void hgrn_passC(const Ctx& c, const float* LF, const bf16_t* HQ, const bf16_t* HV, const bf16_t* HG, const bf16_t* SS, bf16_t* MIXED) {
    const int h = c.wave >> 1, dir = c.wave & 1, lane = c.lane, fr = lane & 15, fq = lane >> 4;
    LAS bf16_t* bA = (LAS bf16_t*)(c.lds + c.wave * 18432);
    LAS bf16_t* bB = bA + 64 * 72;
    for (int n = c.bid; n < 256; n += c.G) {
        const float* lfp = LF + ((size_t)dir * S + n * 64) * 256 + h * 64 + lane;
        const bf16_t* qp = HQ + (size_t)(n * 64) * 256 + h * 64 + lane;
        float b[64]; unsigned qi[32];
#pragma unroll
        for (int t = 0; t < 64; ++t) { b[t] = lfp[(size_t)t * 256]; if ((t & 15) == 15) asm volatile("" ::: "memory"); }
        if (dir == 0) {
#pragma unroll
            for (int t = 1; t < 64; ++t) b[t] += b[t - 1];
        } else {
#pragma unroll
            for (int t = 62; t >= 0; --t) b[t] += b[t + 1];
        }
        const float ref = dir == 0 ? b[31] : b[32];
#pragma unroll
        for (int t2 = 0; t2 < 32; ++t2) { float qiv[2];
#pragma unroll
            for (int o = 0; o < 2; ++o) { const int t = 2 * t2 + o;
                float prev; if (dir == 0) prev = (t == 0) ? 0.f : b[t - 1]; else prev = (t == 63) ? 0.f : b[t + 1];
                const float lf = b[t] - prev; const float kv = 1.f - __expf(lf); const float q = bf2f(qp[(size_t)t * 256]);
                const float qe = q * __expf(fminf(b[t] - ref, 80.f)), ke = kv * __expf(fminf(ref - b[t], 80.f)); qiv[o] = q * __expf(b[t]);
                bA[t * 72 + lane] = f2bf(qe); bB[t * 72 + lane] = f2bf(ke); }
            qi[t2] = cvt_pk_bf16(qiv[0], qiv[1]); if ((t2 & 7) == 7) asm volatile("" ::: "memory"); }
        LDS_WAIT();
        f32x4 sc[4][4];
#pragma unroll
        for (int a = 0; a < 4; ++a)
#pragma unroll
            for (int bb = 0; bb < 4; ++bb) sc[a][bb] = (f32x4){0.f, 0.f, 0.f, 0.f};
#pragma unroll
        for (int kk = 0; kk < 2; ++kk) { bf16x8 a[4], bq[4];
#pragma unroll
            for (int t = 0; t < 4; ++t) { a[t] = *(const LAS bf16x8*)(bA + (16 * t + fr) * 72 + 32 * kk + 8 * fq); bq[t] = *(const LAS bf16x8*)(bB + (16 * t + fr) * 72 + 32 * kk + 8 * fq); }
#pragma unroll
            for (int mt = 0; mt < 4; ++mt)
#pragma unroll
                for (int nt = 0; nt < 4; ++nt) sc[mt][nt] = mfma16(a[mt], bq[nt], sc[mt][nt]); }
        LDS_WAIT();
#pragma unroll
        for (int mt = 0; mt < 4; ++mt)
#pragma unroll
            for (int nt = 0; nt < 4; ++nt)
#pragma unroll
                for (int j = 0; j < 4; ++j) { const int t = 16 * mt + 4 * fq + j, s = 16 * nt + fr; const bool ok = dir == 0 ? (s <= t) : (s >= t);
                    bA[t * 72 + s] = f2bf(ok ? sc[mt][nt][j] : 0.f); }
        { const bf16_t* vp = HV + (size_t)(n * 64) * 256 + h * 64 + lane; unsigned vv[64];
#pragma unroll
            for (int t = 0; t < 64; ++t) { vv[t] = vp[(size_t)t * 256]; if ((t & 15) == 15) asm volatile("" ::: "memory"); }
#pragma unroll
            for (int i = 0; i < 8; ++i) { u32x4 w; w.x = vv[8 * i] | (vv[8 * i + 1] << 16); w.y = vv[8 * i + 2] | (vv[8 * i + 3] << 16); w.z = vv[8 * i + 4] | (vv[8 * i + 5] << 16); w.w = vv[8 * i + 6] | (vv[8 * i + 7] << 16);
                *(LAS u32x4*)(bB + lane * 72 + 8 * i) = w; } }
        LDS_WAIT();
        f32x4 o[4][4];
#pragma unroll
        for (int a = 0; a < 4; ++a)
#pragma unroll
            for (int bb = 0; bb < 4; ++bb) o[a][bb] = (f32x4){0.f, 0.f, 0.f, 0.f};
#pragma unroll
        for (int kk = 0; kk < 2; ++kk) { bf16x8 a[4], bq[4];
#pragma unroll
            for (int t = 0; t < 4; ++t) { a[t] = *(const LAS bf16x8*)(bA + (16 * t + fr) * 72 + 32 * kk + 8 * fq); bq[t] = *(const LAS bf16x8*)(bB + (16 * t + fr) * 72 + 32 * kk + 8 * fq); }
#pragma unroll
            for (int mt = 0; mt < 4; ++mt)
#pragma unroll
                for (int nt = 0; nt < 4; ++nt) o[mt][nt] = mfma16(a[mt], bq[nt], o[mt][nt]); }
        LDS_WAIT();
#pragma unroll
        for (int t2 = 0; t2 < 32; ++t2) { bA[(2 * t2) * 72 + lane] = (bf16_t)(qi[t2] & 0xffffu); bA[(2 * t2 + 1) * 72 + lane] = (bf16_t)(qi[t2] >> 16); }
        { const bf16_t* sp = SS + ((size_t)(n * 2 + dir) * 4 + h) * 4096;
#pragma unroll
            for (int i = 0; i < 8; ++i) { const int ci = i * 64 + lane; const u32x4 w = *(const u32x4*)(sp + ci * 8); *(LAS u32x4*)(bB + (ci >> 3) * 72 + 8 * (ci & 7)) = w; } }
        LDS_WAIT();
#pragma unroll
        for (int kk = 0; kk < 2; ++kk) { bf16x8 a[4], bq[4];
#pragma unroll
            for (int t = 0; t < 4; ++t) { a[t] = *(const LAS bf16x8*)(bA + (16 * t + fr) * 72 + 32 * kk + 8 * fq); bq[t] = *(const LAS bf16x8*)(bB + (16 * t + fr) * 72 + 32 * kk + 8 * fq); }
#pragma unroll
            for (int mt = 0; mt < 4; ++mt)
#pragma unroll
                for (int nt = 0; nt < 4; ++nt) o[mt][nt] = mfma16(a[mt], bq[nt], o[mt][nt]); }
        LDS_WAIT();
        LAS float* ox = (LAS float*)bA;
        if (dir == 1) {
#pragma unroll
            for (int mt = 0; mt < 4; ++mt)
#pragma unroll
                for (int nt = 0; nt < 4; ++nt)
#pragma unroll
                    for (int j = 0; j < 4; ++j) ox[(16 * mt + 4 * fq + j) * 72 + 16 * nt + fr] = o[mt][nt][j];
        }
        __syncthreads();
        if (dir == 0) {
            const LAS float* px = (const LAS float*)(c.lds + (c.wave + 1) * 18432);
#pragma unroll
            for (int mt = 0; mt < 4; ++mt)
#pragma unroll
                for (int j = 0; j < 4; ++j) { const int t = 16 * mt + 4 * fq + j; float ss = 0.f;
#pragma unroll
                    for (int nt = 0; nt < 4; ++nt) { const float v = o[mt][nt][j] + px[t * 72 + 16 * nt + fr]; o[mt][nt][j] = v; ss += v * v; }
                    ss += __shfl_xor(ss, 1); ss += __shfl_xor(ss, 2); ss += __shfl_xor(ss, 4); ss += __shfl_xor(ss, 8);
                    const float rs = 1.f / sqrtf(ss * (1.f / 64.f) + 1e-6f);
                    const size_t ro = (size_t)(n * 64 + t);
#pragma unroll
                    for (int nt = 0; nt < 4; ++nt) { const int col = h * 64 + 16 * nt + fr; const float g = bf2f(HG[ro * 256 + col]); MIXED[ro * 1024 + col] = f2bf(o[mt][nt][j] * rs * g); } }
        }
        __syncthreads();
    }
}

__device__ __forceinline__ void attn_phase(const Ctx& c, const bf16_t* AQ, const bf16_t* AK, const bf16_t* AV, bf16_t* OP, float* LSE) {
    const int tid = c.tid, lane = c.lane, w = c.wave, fr = lane & 15, fq = lane >> 4;
    LAS bf16_t* Ks = (LAS bf16_t*)(c.lds);
    LAS bf16_t* Vt = (LAS bf16_t*)(c.lds + 36864);
    LAS bf16_t* Pw = (LAS bf16_t*)(c.lds + 70656 + w * 5376);
    for (int it = c.bid; it < 3072; it += c.G) {
        const int p = it >> 10, rem = it & 1023, h = rem >> 7, gi = rem & 127;
        const int dsh = 2 * p, d = 1 << dsh, Lp = S >> dsh, ngs = 7 - dsh;
        const int r = gi >> ngs, Jb = (gi & ((1 << ngs) - 1)) * 128;
#pragma unroll
        for (int ps = 0; ps < 4; ++ps) { const int kl = ps * 64 + (tid >> 3), ch = tid & 7; const int J = Jb - 64 + kl; const bool ok = (J >= 0) && (J < Lp);
            u32x4 kv = (u32x4){0u, 0u, 0u, 0u}, vv = (u32x4){0u, 0u, 0u, 0u};
            if (ok) { const size_t off = ((size_t)(J * d + r)) * 512 + h * 64 + 8 * ch; kv = *(const u32x4*)(AK + off); vv = *(const u32x4*)(AV + off); }
            *(LAS u32x4*)(Ks + kl * 72 + 8 * ch) = kv;
            LAS bf16_t* vd = Vt + (8 * ch) * 264 + kl;
            vd[0 * 264] = (bf16_t)(vv.x & 0xffffu); vd[1 * 264] = (bf16_t)(vv.x >> 16); vd[2 * 264] = (bf16_t)(vv.y & 0xffffu); vd[3 * 264] = (bf16_t)(vv.y >> 16);
            vd[4 * 264] = (bf16_t)(vv.z & 0xffffu); vd[5 * 264] = (bf16_t)(vv.z >> 16); vd[6 * 264] = (bf16_t)(vv.w & 0xffffu); vd[7 * 264] = (bf16_t)(vv.w >> 16); }
        __syncthreads();
        const int J0 = Jb + 16 * w, kb = 16 * w;
        bf16x8 qf[2];
        { const size_t qo = ((size_t)((J0 + fr) * d + r)) * 512 + h * 64 + 8 * fq; qf[0] = *(const bf16x8*)(AQ + qo); qf[1] = *(const bf16x8*)(AQ + qo + 32); }
        f32x4 sc[10];
#pragma unroll
        for (int tt = 0; tt < 10; ++tt) { sc[tt] = (f32x4){0.f, 0.f, 0.f, 0.f};
#pragma unroll
            for (int kk = 0; kk < 2; ++kk) { const bf16x8 b = *(const LAS bf16x8*)(Ks + (kb + 16 * tt + fr) * 72 + 32 * kk + 8 * fq); sc[tt] = mfma16(qf[kk], b, sc[tt]); } }
        float mx[4], ls[4];
#pragma unroll
        for (int j = 0; j < 4; ++j) mx[j] = -1e30f;
#pragma unroll
        for (int tt = 0; tt < 10; ++tt) { const int Jk = Jb - 64 + kb + 16 * tt + fr;
#pragma unroll
            for (int j = 0; j < 4; ++j) { const int Jq = J0 + 4 * fq + j; int df = Jq - Jk; df = df < 0 ? -df : df; const bool ok = (Jk >= 0) && (Jk < Lp) && (df <= 64);
                sc[tt][j] = ok ? sc[tt][j] : -1e30f; mx[j] = fmaxf(mx[j], sc[tt][j]); } }
#pragma unroll
        for (int j = 0; j < 4; ++j) { mx[j] = fmaxf(mx[j], __shfl_xor(mx[j], 1)); mx[j] = fmaxf(mx[j], __shfl_xor(mx[j], 2)); mx[j] = fmaxf(mx[j], __shfl_xor(mx[j], 4)); mx[j] = fmaxf(mx[j], __shfl_xor(mx[j], 8)); ls[j] = 0.f; }
#pragma unroll
        for (int tt = 0; tt < 10; ++tt)
#pragma unroll
            for (int j = 0; j < 4; ++j) { const float pv = (sc[tt][j] > -1e29f) ? __expf(sc[tt][j] - mx[j]) : 0.f; ls[j] += pv; Pw[(4 * fq + j) * 168 + 16 * tt + fr] = f2bf(pv); }
#pragma unroll
        for (int j = 0; j < 4; ++j) { ls[j] += __shfl_xor(ls[j], 1); ls[j] += __shfl_xor(ls[j], 2); ls[j] += __shfl_xor(ls[j], 4); ls[j] += __shfl_xor(ls[j], 8); }
        LDS_WAIT();
        f32x4 o[4];
#pragma unroll
        for (int nt = 0; nt < 4; ++nt) o[nt] = (f32x4){0.f, 0.f, 0.f, 0.f};
#pragma unroll
        for (int k2 = 0; k2 < 5; ++k2) { const bf16x8 a = *(const LAS bf16x8*)(Pw + fr * 168 + 32 * k2 + 8 * fq);
#pragma unroll
            for (int nt = 0; nt < 4; ++nt) { const bf16x8 b = *(const LAS bf16x8*)(Vt + (16 * nt + fr) * 264 + kb + 32 * k2 + 8 * fq); o[nt] = mfma16(a, b, o[nt]); } }
#pragma unroll
        for (int j = 0; j < 4; ++j) { const size_t pos = (size_t)((J0 + 4 * fq + j) * d + r); const float inv = 1.f / ls[j];
#pragma unroll
            for (int nt = 0; nt < 4; ++nt) OP[((size_t)p * S + pos) * 512 + h * 64 + 16 * nt + fr] = f2bf(o[nt][j] * inv);
            if (fr == 0) LSE[((size_t)p * S + pos) * 8 + h] = mx[j] + logf(ls[j]); }
        __syncthreads();
    }
}
__device__ __forceinline__ void attn_combine(const bf16_t* OP, const float* LSE, bf16_t* MIXED, int wid, int nw, int tid) {
    for (int e = wid * NTHR + tid; e < S * 64; e += nw * NTHR) { const int s = e >> 6, h = (e >> 3) & 7, ch = e & 7;
        float l0 = LSE[((size_t)0 * S + s) * 8 + h], l1 = LSE[((size_t)1 * S + s) * 8 + h], l2 = LSE[((size_t)2 * S + s) * 8 + h];
        const float m = fmaxf(l0, fmaxf(l1, l2)); l0 = __expf(l0 - m); l1 = __expf(l1 - m); l2 = __expf(l2 - m); const float inv = 1.f / (l0 + l1 + l2); l0 *= inv; l1 *= inv; l2 *= inv;
        const size_t off = (size_t)s * 512 + h * 64 + 8 * ch;
        const u32x4 a = *(const u32x4*)(OP + off), b = *(const u32x4*)(OP + (size_t)S * 512 + off), cc = *(const u32x4*)(OP + (size_t)2 * S * 512 + off);
        u32x4 o;
#pragma unroll
        for (int i = 0; i < 4; ++i) { const float lo = l0 * __uint_as_float(a[i] << 16) + l1 * __uint_as_float(b[i] << 16) + l2 * __uint_as_float(cc[i] << 16);
            const float hi = l0 * __uint_as_float(a[i] & 0xffff0000u) + l1 * __uint_as_float(b[i] & 0xffff0000u) + l2 * __uint_as_float(cc[i] & 0xffff0000u); o[i] = cvt_pk_bf16(lo, hi); }
        *(u32x4*)(MIXED + (size_t)s * 1024 + 512 + h * 64 + 8 * ch) = o; }
}

__device__ __forceinline__ void fft_f1(const Ctx& c, const bf16_t* FU, const bf16_t* WC, const bf16_t* WSn, const float* TW, bf16_t* TP) {
    const int tid = c.tid, lane = c.lane, w = c.wave, fr = lane & 15, fq = lane >> 4;
    LAS bf16_t* UT2 = (LAS bf16_t*)c.lds;
    for (int it = c.bid; it < 256; it += c.G) {
        const int s2 = it >> 1, half = it & 1;
#pragma unroll
        for (int ps = 0; ps < 4; ++ps) { const int s1 = ps * 32 + (tid >> 4), ch = tid & 15;
            const u32x4 v = *(const u32x4*)(FU + (size_t)(128 * s1 + s2) * 256 + half * 128 + 8 * ch);
            LAS bf16_t* dp = UT2 + (8 * ch) * 136 + s1;
            dp[0 * 136] = (bf16_t)(v.x & 0xffffu); dp[1 * 136] = (bf16_t)(v.x >> 16); dp[2 * 136] = (bf16_t)(v.y & 0xffffu); dp[3 * 136] = (bf16_t)(v.y >> 16);
            dp[4 * 136] = (bf16_t)(v.z & 0xffffu); dp[5 * 136] = (bf16_t)(v.z >> 16); dp[6 * 136] = (bf16_t)(v.w & 0xffffu); dp[7 * 136] = (bf16_t)(v.w >> 16); }
        __syncthreads();
        f32x4 re[8], im[8];
#pragma unroll
        for (int mt = 0; mt < 8; ++mt) { re[mt] = (f32x4){0.f, 0.f, 0.f, 0.f}; im[mt] = (f32x4){0.f, 0.f, 0.f, 0.f}; }
#pragma unroll 1
        for (int kk = 0; kk < 4; ++kk) { const bf16x8 b = *(const LAS bf16x8*)(UT2 + (16 * w + fr) * 136 + 32 * kk + 8 * fq);
#pragma unroll
            for (int mt = 0; mt < 8; ++mt) { const bf16x8 ac = *(const bf16x8*)(WC + (16 * mt + fr) * 128 + 32 * kk + 8 * fq), as = *(const bf16x8*)(WSn + (16 * mt + fr) * 128 + 32 * kk + 8 * fq);
                re[mt] = mfma16(ac, b, re[mt]); im[mt] = mfma16(as, b, im[mt]); } }
        const int cg_ = half * 128 + 16 * w + fr;
#pragma unroll
        for (int mt = 0; mt < 8; ++mt)
#pragma unroll
            for (int j = 0; j < 4; ++j) { const int p1 = 16 * mt + 4 * fq + j; const f32x2 tw = *(const f32x2*)(TW + 2 * (s2 * 128 + p1));
                const float tr = re[mt][j], ti = -im[mt][j]; const float orr = tr * tw[0] + ti * tw[1], oi = ti * tw[0] - tr * tw[1];
                bf16_t* op = TP + ((size_t)p1 * 128 + s2) * 512 + cg_; op[0] = f2bf(orr); op[256] = f2bf(oi); }
        __syncthreads();
    }
}
__device__ __forceinline__ void fft_f3(const Ctx& c, int wid, int nw, const bf16_t* TP, const bf16_t* WC, const bf16_t* WSn, const bf16_t* C64, const bf16_t* S64, bf16_t* MIXED) {
    const int tid = c.tid, lane = c.lane, w = c.wave, fr = lane & 15, fq = lane >> 4;
    LAS bf16_t* TrT = (LAS bf16_t*)c.lds;
    LAS bf16_t* TiT = (LAS bf16_t*)(c.lds + 17408);
    LAS bf16_t* XB = (LAS bf16_t*)(c.lds + 34816 + w * 4352);
    for (int it = wid; it < 512; it += nw) {
        const int p1 = it >> 2, g = it & 3;
        { const int s2 = tid >> 2, ch = tid & 3; const bf16_t* src = TP + ((size_t)p1 * 128 + s2) * 512 + g * 64 + 16 * ch;
            const u32x4 r0 = *(const u32x4*)src, r1 = *(const u32x4*)(src + 8), i0 = *(const u32x4*)(src + 256), i1 = *(const u32x4*)(src + 264);
            LAS bf16_t* dr = TrT + (16 * ch) * 136 + s2; LAS bf16_t* di = TiT + (16 * ch) * 136 + s2;
#pragma unroll
            for (int q = 0; q < 4; ++q) { dr[(2 * q) * 136] = (bf16_t)(r0[q] & 0xffffu); dr[(2 * q + 1) * 136] = (bf16_t)(r0[q] >> 16); dr[(8 + 2 * q) * 136] = (bf16_t)(r1[q] & 0xffffu); dr[(9 + 2 * q) * 136] = (bf16_t)(r1[q] >> 16);
                di[(2 * q) * 136] = (bf16_t)(i0[q] & 0xffffu); di[(2 * q + 1) * 136] = (bf16_t)(i0[q] >> 16); di[(8 + 2 * q) * 136] = (bf16_t)(i1[q] & 0xffffu); di[(9 + 2 * q) * 136] = (bf16_t)(i1[q] >> 16); } }
        __syncthreads();
        f32x4 xr[4], xi[4];
#pragma unroll
        for (int nt = 0; nt < 4; ++nt) { xr[nt] = (f32x4){0.f, 0.f, 0.f, 0.f}; xi[nt] = (f32x4){0.f, 0.f, 0.f, 0.f}; }
#pragma unroll
        for (int kk = 0; kk < 4; ++kk) { const bf16x8 ac = *(const bf16x8*)(WC + (16 * w + fr) * 128 + 32 * kk + 8 * fq), as = *(const bf16x8*)(WSn + (16 * w + fr) * 128 + 32 * kk + 8 * fq);
            bf16x8 ans;
#pragma unroll
            for (int e = 0; e < 8; ++e) ans[e] = (short)(as[e] ^ (short)0x8000);
#pragma unroll
            for (int nt = 0; nt < 4; ++nt) { const bf16x8 br = *(const LAS bf16x8*)(TrT + (16 * nt + fr) * 136 + 32 * kk + 8 * fq), bi = *(const LAS bf16x8*)(TiT + (16 * nt + fr) * 136 + 32 * kk + 8 * fq);
                xr[nt] = mfma16(ac, br, xr[nt]); xr[nt] = mfma16(as, bi, xr[nt]); xi[nt] = mfma16(ac, bi, xi[nt]); xi[nt] = mfma16(ans, br, xi[nt]); } }
#pragma unroll
        for (int nt = 0; nt < 4; ++nt)
#pragma unroll
            for (int j = 0; j < 4; ++j) { XB[(4 * fq + j) * 136 + 16 * nt + fr] = f2bf(xr[nt][j]); XB[(4 * fq + j) * 136 + 64 + 16 * nt + fr] = f2bf(xi[nt][j]); }
        LDS_WAIT();
        f32x4 y[4];
#pragma unroll
        for (int nt = 0; nt < 4; ++nt) y[nt] = (f32x4){0.f, 0.f, 0.f, 0.f};
#pragma unroll
        for (int kk = 0; kk < 4; ++kk) { const bf16x8 a = *(const LAS bf16x8*)(XB + fr * 136 + 32 * kk + 8 * fq); const bf16_t* tb = (kk < 2) ? C64 : S64;
#pragma unroll
            for (int nt = 0; nt < 4; ++nt) { const bf16x8 b = *(const bf16x8*)(tb + (16 * nt + fr) * 64 + 32 * (kk & 1) + 8 * fq); y[nt] = mfma16(a, b, y[nt]); } }
#pragma unroll
        for (int j = 0; j < 4; ++j) { const size_t prow = (size_t)(p1 + 128 * (16 * w + 4 * fq + j));
#pragma unroll
            for (int nt = 0; nt < 4; ++nt) MIXED[prow * 1024 + 256 + g * 64 + 16 * nt + fr] = f2bf(y[nt][j] * (1.f / 1024.f)); }
        __syncthreads();
    }
}

constexpr int PH_PER_LAYER = 9, N_PHASES = DEPTH * PH_PER_LAYER + 1;
__global__ void __launch_bounds__(NTHR, 2) mega(P p) {
    extern __shared__ __attribute__((aligned(16))) unsigned char lds_raw[];
    cg::grid_group grid = cg::this_grid();
#define WSL unsigned char* ws = p.ws; asm volatile("" : "+s"(ws))
    for (int gp = p.ph_lo; gp < p.ph_hi; ++gp) {
        const int layer = gp / PH_PER_LAYER, ph = gp % PH_PER_LAYER;
        Ctx c; c.lds = (LAS unsigned char*)lds_raw; { int t_ = threadIdx.x; asm volatile("" : "+v"(t_)); c.tid = t_; } c.lane = c.tid & 63; c.wave = __builtin_amdgcn_readfirstlane(c.tid >> 6); c.bid = blockIdx.x; c.G = gridDim.x;
        if (gp == N_PHASES - 1) {
            norm_rows(c, p.out, p.fnw, nullptr, p.out);
        } else if (ph == 0) {
#ifndef NO_TAB
            if (layer == 0) make_tables(c, p);
#endif
            convert_weights(c, p, layer);
            WSL;
            norm_rows(c, layer == 0 ? p.x : p.out, p.anw + layer * D, (bf16_t*)(ws + WS_XN), nullptr);
        } else if (ph == 1) {
            WSL;
            pg8::Gemm g{(const bf16_t*)(ws + WS_XN), (const bf16_t*)(ws + W_IN), S, NIN, D}; pg8::StaticOrder so; so.init(S, NIN, c.G, c.bid);
            EpiIn E{(bf16_t*)(ws + WS_HQ), (bf16_t*)(ws + WS_HV), (bf16_t*)(ws + WS_HG), (bf16_t*)(ws + WS_FU), (bf16_t*)(ws + WS_AQ), (bf16_t*)(ws + WS_AK), (bf16_t*)(ws + WS_AV), (float*)(ws + WS_LF),
                    (const float*)(ws + OFF_LB) + layer * 512, (const float*)(ws + OFF_CS)};
            pg8::gemm_phase<EpiIn, pg8::StaticOrder, false>(c.lds, g, so, E, nullptr);
        } else if (ph == 2) {
#ifndef NO_PA
            { WSL; hgrn_passA(c, (const float*)(ws + WS_LF), (const bf16_t*)(ws + WS_HV), (float*)(ws + WS_UT), (float*)(ws + WS_DEC)); }
#endif
#ifndef NO_ATT
            { WSL; attn_phase(c, (const bf16_t*)(ws + WS_AQ), (const bf16_t*)(ws + WS_AK), (const bf16_t*)(ws + WS_AV), (bf16_t*)(ws + WS_OP), (float*)(ws + WS_LSE)); }
#endif
#ifndef NO_F1
            { WSL; fft_f1(c, (const bf16_t*)(ws + WS_FU), (const bf16_t*)(ws + OFF_W128C), (const bf16_t*)(ws + OFF_W128S), (const float*)(ws + OFF_TW), (bf16_t*)(ws + WS_TP)); }
#endif
        } else if (ph == 3) {
            WSL;
            const float* UT = (const float*)(ws + WS_UT); const float* DEC = (const float*)(ws + WS_DEC); bf16_t* SS = (bf16_t*)(ws + WS_SS);
            const int nscan = (c.G >= 128) ? 64 : 0;
            if (c.bid < nscan) { for (int e = c.bid * NTHR + c.tid; e < 32768; e += nscan * NTHR) hgrn_scan(e, UT, DEC, SS); }
            else { if (nscan == 0) { for (int e = c.bid * NTHR + c.tid; e < 32768; e += c.G * NTHR) hgrn_scan(e, UT, DEC, SS); }
                const int wid = c.bid - nscan, nw = c.G - nscan;
#ifndef NO_F3
                fft_f3(c, wid, nw, (const bf16_t*)(ws + WS_TP), (const bf16_t*)(ws + OFF_W128C), (const bf16_t*)(ws + OFF_W128S), (const bf16_t*)(ws + OFF_C64), (const bf16_t*)(ws + OFF_S64), (bf16_t*)(ws + WS_MIXED));
#endif
                attn_combine((const bf16_t*)(ws + WS_OP), (const float*)(ws + WS_LSE), (bf16_t*)(ws + WS_MIXED), wid, nw, c.tid); }
        } else if (ph == 4) {
#ifndef NO_PC
            WSL;
            hgrn_passC(c, (const float*)(ws + WS_LF), (const bf16_t*)(ws + WS_HQ), (const bf16_t*)(ws + WS_HV), (const bf16_t*)(ws + WS_HG), (const bf16_t*)(ws + WS_SS), (bf16_t*)(ws + WS_MIXED));
#endif
        } else if (ph == 5) {
            WSL;
            pg8::Gemm g{(const bf16_t*)(ws + WS_MIXED), (const bf16_t*)(ws + W_OUT), S, D, D}; pg8::StaticOrder so; so.init(S, D, c.G, c.bid);
            EpiRes E{layer == 0 ? p.x : p.out, p.out, D};
            pg8::gemm_phase<EpiRes, pg8::StaticOrder, false>(c.lds, g, so, E, nullptr);
        } else if (ph == 6) {
            WSL;
            norm_rows(c, p.out, p.mnw + layer * D, (bf16_t*)(ws + WS_XN), nullptr);
        } else if (ph == 7) {
            WSL;
            pg8::Gemm g{(const bf16_t*)(ws + WS_XN), (const bf16_t*)(ws + W_UP), S, FF, D}; pg8::StaticOrder so; so.init(S, FF, c.G, c.bid);
            EpiUp E{(bf16_t*)(ws + WS_H), FF};
            pg8::gemm_phase<EpiUp, pg8::StaticOrder, false>(c.lds, g, so, E, nullptr);
        } else {
            WSL;
            pg8::Gemm g{(const bf16_t*)(ws + WS_H), (const bf16_t*)(ws + W_DOWN), S, D, FF}; pg8::StaticOrder so; so.init(S, D, c.G, c.bid);
            EpiRes E{p.out, p.out, D};
            pg8::gemm_phase<EpiRes, pg8::StaticOrder, false>(c.lds, g, so, E, nullptr);
        }
        if (gp + 1 < p.ph_hi) grid.sync();
    }
}
}

extern "C" void kernel_launch(void* const* d_in, const int* in_sizes, int n_in, void* d_out, int out_size, void* d_ws, size_t ws_size, hipStream_t stream) {
    static int grid = 0;
    if (grid == 0) {
        int dev = 0, cus = 0, per_cu = 0;
        hipGetDevice(&dev);
        hipDeviceGetAttribute(&cus, hipDeviceAttributeMultiprocessorCount, dev);
        if (hipFuncSetAttribute((const void*)mk::mega, hipFuncAttributeMaxDynamicSharedMemorySize, mk::LDS_BYTES) != hipSuccess) fprintf(stderr, "kernel_launch: hipFuncSetAttribute failed\n");
        if (hipOccupancyMaxActiveBlocksPerMultiprocessor(&per_cu, (const void*)mk::mega, mk::NTHR, mk::LDS_BYTES) != hipSuccess || per_cu < 1) { fprintf(stderr, "kernel_launch: occupancy query says %d\n", per_cu); per_cu = 1; }
        (void)hipGetLastError();
        grid = cus * per_cu; if (grid > 256) grid = 256; if (grid < 1) grid = 256;
    }
    mk::P p{};
    p.x = (const float*)d_in[0]; p.pos = (const int*)d_in[1]; p.anw = (const float*)d_in[2]; p.w_in = (const float*)d_in[3]; p.lbs = (const float*)d_in[4]; p.w_out = (const float*)d_in[5];
    p.mnw = (const float*)d_in[6]; p.w_up = (const float*)d_in[7]; p.w_down = (const float*)d_in[8]; p.fnw = (const float*)d_in[9]; p.out = (float*)d_out; p.ws = (unsigned char*)d_ws;
    p.ph_lo = 0; p.ph_hi = mk::N_PHASES;
    void* args[] = {&p};
    hipError_t e = hipLaunchCooperativeKernel((const void*)mk::mega, dim3(grid), dim3(mk::NTHR), args, mk::LDS_BYTES, stream);
    if (e != hipSuccess) fprintf(stderr, "kernel_launch: cooperative launch failed: %s (grid %d)\n", hipGetErrorString(e), grid);
}
```

```cpp
#include <hip/hip_runtime.h>
namespace pg8 {
#define PG8_LAS __attribute__((address_space(3)))
typedef unsigned short bf16_t;
typedef short bf16x8 __attribute__((ext_vector_type(8)));
typedef float f32x4 __attribute__((ext_vector_type(4)));
typedef unsigned u32x4 __attribute__((ext_vector_type(4)));
constexpr int BM = 256, BK = 64, HALF = 128, HTB = HALF * BK * 2  , STAGE_BYTES = 8 * HTB, NXCD = 8, WGM = 8;

__host__ __device__ __forceinline__ int lds_byte(int r, int c) { const int st = (r >> 4) * 2 + (c >> 5), rr = r & 15, cc = c & 31, ob = rr * 64 + cc * 2; return st * 1024 + (ob ^ (((ob >> 9) & 1) << 5)); }
__host__ __device__ __forceinline__ void stage_rc(int b, int& R, int& C) { const int st = b / 1024, sb = b % 1024, swz = sb ^ (((sb >> 9) & 1) << 5); R = (st >> 1) * 16 + swz / 64; C = (st & 1) * 32 + (swz % 64) / 2; }
__host__ __device__ __forceinline__ int perm32(int rho) { const int n = rho >> 4, i = rho & 15; return 8 * (i >> 2) + 4 * n + (i & 3); }

struct Unit { int pm, pn; };
struct Gemm { const bf16_t* A; const bf16_t* Bt; int M, N, K; };

struct StaticOrder {
    int nM, nN, nwg, G, c;
    __host__ __device__ void init(int M, int N, int G_, int c_) { nM = M / BM; nN = N / BM; nwg = nM * nN; G = G_; c = c_; }
    __host__ __device__ bool next(int i, Unit& u) const {
        const long L = (long)i * G + c; if (L >= nwg) return false;
        int wgid = (int)L; { const int q = nwg / NXCD, r = nwg % NXCD, xcd = wgid % NXCD, off = wgid / NXCD; wgid = (xcd < r ? xcd * (q + 1) : r * (q + 1) + (xcd - r) * q) + off; }
        const int nig = WGM * nN, gid = wgid / nig, fm = gid * WGM, gsz = (nM - fm) < WGM ? (nM - fm) : WGM;
        u.pm = fm + ((wgid % nig) % gsz); u.pn = (wgid % nig) / gsz; return true;
    }
    __device__ __forceinline__ void a_ready(const Unit&) const {}
    __device__ __forceinline__ void done(const Unit&) const {}
};
__device__ __forceinline__ unsigned cvt_pk_bf16(float lo, float hi) { unsigned r; asm volatile("v_cvt_pk_bf16_f32 %0, %1, %2" : "=v"(r) : "v"(lo), "v"(hi)); return r; }
typedef float f32x2 __attribute__((ext_vector_type(2)));
template <class Epi, class Sched, bool STAMP = false>
__device__ __forceinline__ void gemm_phase(PG8_LAS unsigned char* lds, const Gemm g, const Sched& S, const Epi& E, unsigned long long* stamps) {
    int tid_l = threadIdx.x; asm volatile("" : "+v"(tid_l)); const int tid = tid_l, wid = __builtin_amdgcn_readfirstlane(tid >> 6), lane = tid & 63, wr = wid >> 2, wc = wid & 3, fr = lane & 15, fq = lane >> 4;
    const int K = g.K, nt = K / BK;
    int ts_lo = 0, ts_hi = 0, nts = 0; const unsigned long long rt_entry = STAMP ? (unsigned long long)wall_clock64() : 0ull;
#define PG8_STAMP() do { if (STAMP && wid == 0 && nts < 64) { const unsigned long long _c = (unsigned long long)clock64(); \
        ts_lo = (lane == nts) ? (int)(unsigned)_c : ts_lo; ts_hi = (lane == nts) ? (int)(unsigned)(_c >> 32) : ts_hi; ++nts; } } while (0)
    PG8_STAMP();
    unsigned voffA[2], voffB[2];
#pragma unroll
    for (int i = 0; i < 2; ++i) { int R, C; stage_rc(tid * 16 + i * 8192, R, C); const int Rb = Epi::PERM ? ((R & ~31) + perm32(R & 31)) : R;
        voffA[i] = (unsigned)(R * K + C) * 2u; voffB[i] = (unsigned)(Rb * K + C) * 2u; }
    const size_t kstep = (size_t)(BK * 2);
    const size_t hstep = (size_t)HALF * K * 2;
    const size_t tstep = 2 * hstep;
    const unsigned ldsw = (unsigned)wid * 1024u;
    const int aoff = lds_byte(wr * 64 + fr, fq * 8), boff = lds_byte(wc * 32 + fr, fq * 8);
#define PG8_SA(b, h) (((b) * 2 + (h)) * HTB)
#define PG8_SB(b, h) ((4 + (b) * 2 + (h)) * HTB)
#define PG8_STAGE(bufoff, gbase, voff) do { _Pragma("unroll") for (int _i = 0; _i < 2; ++_i) \
        __builtin_amdgcn_global_load_lds((const unsigned*)((const char*)(gbase) + (voff)[_i]), (PG8_LAS unsigned*)(lds + (bufoff) + ldsw + _i * 8192), 16, 0, 0); } while (0)
#define PG8_LDA(dst, b, h) do { _Pragma("unroll") for (int m = 0; m < 4; ++m) _Pragma("unroll") for (int k = 0; k < 2; ++k) dst[m][k] = *(const PG8_LAS bf16x8*)(lds + PG8_SA(b, h) + aoff + m * 2048 + k * 1024); } while (0)
#define PG8_LDB(dst, b, h) do { _Pragma("unroll") for (int n = 0; n < 2; ++n) _Pragma("unroll") for (int k = 0; k < 2; ++k) dst[n][k] = *(const PG8_LAS bf16x8*)(lds + PG8_SB(b, h) + boff + n * 2048 + k * 1024); } while (0)
#define PG8_MMA(ai, bj, At, Bt) do { __builtin_amdgcn_s_setprio(1); _Pragma("unroll") for (int m = 0; m < 4; ++m) _Pragma("unroll") for (int n = 0; n < 2; ++n) _Pragma("unroll") for (int k = 0; k < 2; ++k) \
        acc[ai][bj][m][n] = __builtin_amdgcn_mfma_f32_16x16x32_bf16(Bt[n][k], At[m][k], acc[ai][bj][m][n], 0, 0, 0); __builtin_amdgcn_s_setprio(0); } while (0)
#define PG8_WAIT_V(n) asm volatile("s_waitcnt vmcnt(" #n ")" ::: "memory")
#define PG8_WAIT_L(n) asm volatile("s_waitcnt lgkmcnt(" #n ")" ::: "memory")
#define PG8_BAR __builtin_amdgcn_s_barrier()
#define PG8_SCHED __builtin_amdgcn_sched_barrier(0)
    Unit cur, nxt; int ui = 0;
    if (!S.next(0, cur)) return;
    f32x4 acc[2][2][4][2];
#pragma unroll
    for (int a = 0; a < 2; ++a)
#pragma unroll
        for (int b = 0; b < 2; ++b)
#pragma unroll
            for (int m = 0; m < 4; ++m)
#pragma unroll
                for (int n = 0; n < 2; ++n) acc[a][b][m][n] = (f32x4){0.f, 0.f, 0.f, 0.f};
    if constexpr (Epi::HAS_INIT) E.init(acc, cur, wr, wc, fr, fq);
    bf16x8 At[4][2], B0[2][2], B1[2][2];
    const char* cA = (const char*)g.A + (size_t)cur.pm * tstep; const char* cB = (const char*)g.Bt + (size_t)cur.pn * tstep;
    S.a_ready(cur);
    PG8_STAGE(PG8_SB(0, 0), cB, voffB); PG8_STAGE(PG8_SA(0, 0), cA, voffA); PG8_STAGE(PG8_SB(0, 1), cB + hstep, voffB); PG8_STAGE(PG8_SA(0, 1), cA + hstep, voffA);
    if (wr == 1) PG8_BAR;
    PG8_WAIT_V(4); PG8_BAR;
    PG8_STAGE(PG8_SB(1, 0), cB + kstep, voffB); PG8_STAGE(PG8_SA(1, 0), cA + kstep, voffA); PG8_STAGE(PG8_SB(1, 1), cB + hstep + kstep, voffB);
    PG8_WAIT_V(6); PG8_BAR;
    PG8_STAMP();
    for (;;) {
        const bool has_next = S.next(ui + 1, nxt);
        const char* nA = has_next ? (const char*)g.A + (size_t)nxt.pm * tstep : cA; const char* nB = has_next ? (const char*)g.Bt + (size_t)nxt.pn * tstep : cB;
        for (int t = 0; t < nt; t += 2) {
            const bool last = (t == nt - 2);
            const char* a1 = cA + (size_t)(t + 1) * kstep;
            const char* a2 = last ? nA : cA + (size_t)(t + 2) * kstep; const char* b2 = last ? nB : cB + (size_t)(t + 2) * kstep;
            const char* a3 = a2 + kstep; const char* b3 = b2 + kstep;
            if (last && has_next) S.a_ready(nxt);
            PG8_LDB(B0, 0, 0); PG8_SCHED; PG8_LDA(At, 0, 0); PG8_STAGE(PG8_SA(1, 1), a1 + hstep, voffA);
            PG8_WAIT_L(8); PG8_BAR; PG8_WAIT_L(0); PG8_MMA(0, 0, At, B0); PG8_BAR; PG8_SCHED;
            PG8_LDB(B1, 0, 1); PG8_STAGE(PG8_SB(0, 0), b2, voffB);
            PG8_BAR; PG8_WAIT_L(0); PG8_MMA(0, 1, At, B1); PG8_BAR;
            PG8_LDA(At, 0, 1); PG8_STAGE(PG8_SA(0, 0), a2, voffA);
            PG8_BAR; PG8_WAIT_L(0); PG8_MMA(1, 0, At, B0); PG8_BAR; PG8_SCHED;
            PG8_STAGE(PG8_SB(0, 1), b2 + hstep, voffB);
            PG8_WAIT_V(6); PG8_BAR; PG8_MMA(1, 1, At, B1); PG8_BAR;
            PG8_LDB(B0, 1, 0); PG8_SCHED; PG8_LDA(At, 1, 0); PG8_STAGE(PG8_SA(0, 1), a2 + hstep, voffA);
            PG8_WAIT_L(8); PG8_BAR; PG8_WAIT_L(0); PG8_MMA(0, 0, At, B0); PG8_BAR; PG8_SCHED;
            PG8_LDB(B1, 1, 1); PG8_STAGE(PG8_SB(1, 0), b3, voffB);
            PG8_BAR; PG8_WAIT_L(0); PG8_MMA(0, 1, At, B1); PG8_BAR;
            PG8_LDA(At, 1, 1); PG8_STAGE(PG8_SA(1, 0), a3, voffA);
            PG8_BAR; PG8_WAIT_L(0); PG8_MMA(1, 0, At, B0); PG8_BAR; PG8_SCHED;
            PG8_STAGE(PG8_SB(1, 1), b3 + hstep, voffB);
            PG8_WAIT_V(6); PG8_BAR; PG8_MMA(1, 1, At, B1); PG8_BAR;
        }
        PG8_STAMP();
        if constexpr (!Epi::AFTER_DRAIN) { E(acc, cur, wr, wc, fr, fq); S.done(cur); }
        PG8_STAMP();
        if (!has_next) break;
#pragma unroll
        for (int a = 0; a < 2; ++a)
#pragma unroll
            for (int b = 0; b < 2; ++b)
#pragma unroll
                for (int m = 0; m < 4; ++m)
#pragma unroll
                    for (int n = 0; n < 2; ++n) acc[a][b][m][n] = (f32x4){0.f, 0.f, 0.f, 0.f};
        if constexpr (Epi::HAS_INIT) E.init(acc, nxt, wr, wc, fr, fq);
        cur = nxt; cA = nA; cB = nB; ++ui;
    }
    PG8_WAIT_V(0);
    if (wr == 0) PG8_BAR;
    PG8_BAR;
    if constexpr (Epi::AFTER_DRAIN) { E.fused(acc, cur, wr, wc, fr, fq, lds, wid, lane); S.done(cur); }
    PG8_STAMP();
    if (STAMP && wid == 0) { stamps[lane] = lane < nts ? (((unsigned long long)(unsigned)ts_hi << 32) | (unsigned)ts_lo) : 0ull;
        if (lane == 62) stamps[62] = rt_entry; if (lane == 63) stamps[63] = (unsigned long long)wall_clock64(); }
#undef PG8_STAMP
#undef PG8_SA
#undef PG8_SB
#undef PG8_STAGE
#undef PG8_LDA
#undef PG8_LDB
#undef PG8_MMA
#undef PG8_WAIT_V
#undef PG8_WAIT_L
#undef PG8_BAR
#undef PG8_SCHED
}
}

#include <hip/hip_cooperative_groups.h>
#include <cstdio>
namespace cg = cooperative_groups;
namespace mk {
using pg8::bf16_t; using pg8::bf16x8; using pg8::f32x4; using pg8::u32x4; using pg8::cvt_pk_bf16; using pg8::Unit;
#define LAS __attribute__((address_space(3)))
#define GAS __attribute__((address_space(1)))
typedef unsigned u32x2 __attribute__((ext_vector_type(2)));
typedef float f32x2 __attribute__((ext_vector_type(2)));
typedef _Float16 f16x8 __attribute__((ext_vector_type(8)));

constexpr int S = 16384, D = 1024, NIN = 3072, FF = 4096, DEPTH = 4;
constexpr int NTHR = 512;
constexpr int LDS_BYTES = 151552;
constexpr size_t MiB = (size_t)1 << 20;
constexpr size_t OFF_LB = 0, OFF_W128C = 16384, OFF_W128S = 49152, OFF_C64 = 81920, OFF_S64 = 90112, OFF_TW = 131072, OFF_CS = 1 * MiB;
constexpr size_t OFF_BAR = 524288, BAR_BYTES = 16384, OFF_SSQA = 5 * 1048576, OFF_SSQM = 6 * 1048576;
constexpr int LDS_ST_OFF = 151040;
constexpr size_t WS_W = 8 * MiB, W_IN = WS_W, W_OUT = WS_W + 6 * MiB, W_UP = WS_W + 8 * MiB, W_DOWN = WS_W + 16 * MiB;
constexpr size_t WS_XN = 32 * MiB, WS_UT = 32 * MiB;
constexpr size_t WS_HQ = 64 * MiB, WS_HV = 72 * MiB, WS_HG = 80 * MiB, WS_FU = 88 * MiB, WS_LF = 96 * MiB;
constexpr size_t WS_AQ = 128 * MiB, WS_AK = 144 * MiB, WS_MIXED = 128 * MiB, WS_AV = 160 * MiB, WS_SS = 160 * MiB;
constexpr size_t WS_OP = 176 * MiB, WS_TP = 224 * MiB, WS_DEC = 240 * MiB, WS_LSE = 241 * MiB;
constexpr size_t WS_H = 64 * MiB;

struct P { const float* x; const int* pos; const float* anw; const float* w_in; const float* lbs; const float* w_out; const float* mnw;
           const float* w_up; const float* w_down; const float* fnw; float* out; unsigned char* ws; int ph_lo, ph_hi, dup, pad; };
struct Ctx { LAS unsigned char* lds; int tid, lane, wave, bid, G; };

__device__ __forceinline__ float bf2f(unsigned short b) { return __uint_as_float(((unsigned)b) << 16); }
__device__ __forceinline__ unsigned short f2bf(float f) { return (unsigned short)(cvt_pk_bf16(f, 0.f) & 0xffffu); }
__device__ __forceinline__ f32x4 mfma16(bf16x8 a, bf16x8 b, f32x4 c) { return __builtin_amdgcn_mfma_f32_16x16x32_bf16(a, b, c, 0, 0, 0); }
__device__ __forceinline__ float wave_sum(float v) {
#pragma unroll
    for (int o = 1; o < 64; o <<= 1) v += __shfl_xor(v, o);
    return v;
}
__device__ __forceinline__ float silu(float v) { return v * __builtin_amdgcn_rcpf(1.f + __expf(-v)); }
#define LDS_WAIT() asm volatile("s_waitcnt lgkmcnt(0)" ::: "memory")

constexpr int LDS_RS_OFF = 131072;
__device__ __forceinline__ float row_rs(const float* ssq, int row) { const f32x4* q = (const f32x4*)(ssq + (size_t)row * 16); const f32x4 a = q[0], b = q[1], c = q[2], d = q[3];
    const float s = (((a[0] + a[1]) + (a[2] + a[3])) + ((b[0] + b[1]) + (b[2] + b[3]))) + (((c[0] + c[1]) + (c[2] + c[3])) + ((d[0] + d[1]) + (d[2] + d[3]))); return 1.f / sqrtf(s * (1.f / D) + 1e-6f); }
__device__ __forceinline__ float rs_of(LAS unsigned char* lds, const float* ssq, int pm0, int pm, int row) { return *(const LAS float*)(lds + LDS_RS_OFF + 4 * (row & 255)); }
__device__ __forceinline__ void fill_rs_table(LAS unsigned char* lds, const float* ssq, int pm0, int tid) { if (tid < 256) *(LAS float*)(lds + LDS_RS_OFF + 4 * tid) = row_rs(ssq, pm0 * 256 + tid); __syncthreads(); }
struct EpiRes {
    static constexpr bool PERM = true, AFTER_DRAIN = false, HAS_INIT = true;
    bf16_t* xnb; float* ssq; int ldc; const float* ssq_in; LAS unsigned char* lds; int pm0;
    __device__ __forceinline__ void init(f32x4 (&acc)[2][2][4][2], const Unit& u, int wr, int wc, int fr, int fq) const {
        const int row0 = u.pm * 256 + wr * 64 + fr, col0 = u.pn * 256 + wc * 32 + 8 * fq; const GAS bf16_t* xg = (const GAS bf16_t*)xnb;
#pragma unroll
        for (int ai = 0; ai < 2; ++ai)
#pragma unroll
            for (int m = 0; m < 4; ++m) { const int row = row0 + ai * 128 + m * 16; const size_t off = (size_t)row * ldc + col0;
                float isc = 1.f; if (ssq_in) { const float r = rs_of(lds, ssq_in, pm0, u.pm, row); isc = 1.f / (r * r); }
#pragma unroll
                for (int bj = 0; bj < 2; ++bj) { const u32x4 w = *(const GAS u32x4*)(xg + off + bj * 128);
                    acc[ai][bj][m][0] = (f32x4){__uint_as_float(w.x << 16), __uint_as_float(w.x & 0xffff0000u), __uint_as_float(w.y << 16), __uint_as_float(w.y & 0xffff0000u)} * isc;
                    acc[ai][bj][m][1] = (f32x4){__uint_as_float(w.z << 16), __uint_as_float(w.z & 0xffff0000u), __uint_as_float(w.w << 16), __uint_as_float(w.w & 0xffff0000u)} * isc; } }
    }
    __device__ __forceinline__ void operator()(const f32x4 (&acc)[2][2][4][2], const Unit& u, int wr, int wc, int fr_, int fq_) const {
        int fr = fr_, fq = fq_; asm volatile("" : "+v"(fr), "+v"(fq));
        const int row0 = u.pm * 256 + wr * 64 + fr, col0 = u.pn * 256 + wc * 32 + 8 * fq; GAS bf16_t* xg = (GAS bf16_t*)xnb; GAS float* sg = (GAS float*)ssq;
#pragma unroll
        for (int ai = 0; ai < 2; ++ai)
#pragma unroll
            for (int m = 0; m < 4; ++m) { const int row = row0 + ai * 128 + m * 16; const size_t off = (size_t)row * ldc + col0; float s = 0.f;
                float sc = 1.f; if (ssq_in) { const float r = rs_of(lds, ssq_in, pm0, u.pm, row); sc = r * r; }
#pragma unroll
                for (int bj = 0; bj < 2; ++bj) { const f32x4 v0 = acc[ai][bj][m][0] * sc, v1 = acc[ai][bj][m][1] * sc;
                    s += ((v0[0] * v0[0] + v0[1] * v0[1]) + (v0[2] * v0[2] + v0[3] * v0[3])) + ((v1[0] * v1[0] + v1[1] * v1[1]) + (v1[2] * v1[2] + v1[3] * v1[3]));
                    u32x4 w; w.x = cvt_pk_bf16(v0[0], v0[1]); w.y = cvt_pk_bf16(v0[2], v0[3]); w.z = cvt_pk_bf16(v1[0], v1[1]); w.w = cvt_pk_bf16(v1[2], v1[3]);
                    *(GAS u32x4*)(xg + off + bj * 128) = w; }
                s += __shfl_xor(s, 16); s += __shfl_xor(s, 32);
                if (fq == 0) sg[(size_t)row * 16 + u.pn * 4 + wc] = s; }
    }
};
struct EpiUp {
    static constexpr bool PERM = true, AFTER_DRAIN = false, HAS_INIT = false;
    bf16_t* O; int ldc;
    __device__ __forceinline__ void operator()(const f32x4 (&acc)[2][2][4][2], const Unit& u, int wr, int wc, int fr_, int fq_) const {
        int fr = fr_, fq = fq_; asm volatile("" : "+v"(fr), "+v"(fq));
        const int row0 = u.pm * 256 + wr * 64 + fr, col0 = u.pn * 256 + wc * 32 + 8 * fq;
#pragma unroll
        for (int ai = 0; ai < 2; ++ai)
#pragma unroll
            for (int m = 0; m < 4; ++m) { const int row = row0 + ai * 128 + m * 16; bf16_t* rowp = O + (size_t)row * ldc + col0;
#pragma unroll
                for (int bj = 0; bj < 2; ++bj) { f32x4 v0 = acc[ai][bj][m][0], v1 = acc[ai][bj][m][1];
#pragma unroll
                    for (int e = 0; e < 4; ++e) { float a = fmaxf(v0[e], 0.f), b = fmaxf(v1[e], 0.f); v0[e] = a * a; v1[e] = b * b; }
                    u32x4 w; w.x = cvt_pk_bf16(v0[0], v0[1]); w.y = cvt_pk_bf16(v0[2], v0[3]); w.z = cvt_pk_bf16(v1[0], v1[1]); w.w = cvt_pk_bf16(v1[2], v1[3]);
                    *(GAS u32x4*)((GAS bf16_t*)rowp + bj * 128) = w; } }
    }
};
struct EpiIn {
    static constexpr bool PERM = true, AFTER_DRAIN = false, HAS_INIT = false;
    bf16_t *HQ, *HV, *HG, *FU, *AQ, *AK, *AV; _Float16* LF; const float* LB; const float* CS; const float* ssq; LAS unsigned char* lds; int pm0;
    __device__ __forceinline__ void operator()(const f32x4 (&acc)[2][2][4][2], const Unit& u, int wr, int wc, int fr_, int fq_) const {
        int fr = fr_, fq = fq_; asm volatile("" : "+v"(fr), "+v"(fq));
        const int pn = u.pn; const int row0 = u.pm * 256 + wr * 64 + fr; const int c8 = wc * 32 + 8 * fq;
        if (pn >= 6 && pn <= 9) {
            const bool isq = pn < 8; bf16_t* dst = isq ? AQ : AK; const int headg = (pn - (isq ? 6 : 8)) * 4 + wc; const float sc0 = isq ? 0.125f * 1.4426950408889634f : 1.f; const int i0 = 8 * fq;
#pragma unroll
            for (int ai = 0; ai < 2; ++ai)
#pragma unroll
                for (int m = 0; m < 4; ++m) { const int row = row0 + ai * 128 + m * 16; const float sc = sc0 * rs_of(lds, ssq, pm0, u.pm, row);
                    const GAS f32x4* cs = (const GAS f32x4*)((const GAS float*)CS + ((size_t)row * 32 + i0) * 2);
                    float o1[8], o2[8];
#pragma unroll
                    for (int n = 0; n < 2; ++n)
#pragma unroll
                        for (int e2 = 0; e2 < 2; ++e2) { const f32x4 t = cs[n * 2 + e2];
                            { const int e = 2 * e2; const float x1 = acc[ai][0][m][n][e], x2 = acc[ai][1][m][n][e]; o1[4 * n + e] = (x1 * t[0] - x2 * t[1]) * sc; o2[4 * n + e] = (x2 * t[0] + x1 * t[1]) * sc; }
                            { const int e = 2 * e2 + 1; const float x1 = acc[ai][0][m][n][e], x2 = acc[ai][1][m][n][e]; o1[4 * n + e] = (x1 * t[2] - x2 * t[3]) * sc; o2[4 * n + e] = (x2 * t[2] + x1 * t[3]) * sc; } }
                    u32x4 w1, w2; w1.x = cvt_pk_bf16(o1[0], o1[1]); w1.y = cvt_pk_bf16(o1[2], o1[3]); w1.z = cvt_pk_bf16(o1[4], o1[5]); w1.w = cvt_pk_bf16(o1[6], o1[7]);
                    w2.x = cvt_pk_bf16(o2[0], o2[1]); w2.y = cvt_pk_bf16(o2[2], o2[3]); w2.z = cvt_pk_bf16(o2[4], o2[5]); w2.w = cvt_pk_bf16(o2[6], o2[7]);
                    bf16_t* rp = dst + (size_t)row * 512 + headg * 64 + i0;
                    *(GAS u32x4*)(GAS bf16_t*)rp = w1; *(GAS u32x4*)((GAS bf16_t*)rp + 32) = w2; if (m == 3) asm volatile("" ::: "memory"); }
        } else if (pn == 2 || pn == 3) {
            const int dir = pn - 2;
#pragma unroll
            for (int bj = 0; bj < 2; ++bj) { const int col = bj * 128 + c8; const f32x4 l0 = *(const f32x4*)(LB + dir * 256 + col), l1 = *(const f32x4*)(LB + dir * 256 + col + 4);
#pragma unroll
                for (int ai = 0; ai < 2; ++ai)
#pragma unroll
                    for (int m = 0; m < 4; ++m) { const int row = row0 + ai * 128 + m * 16; f32x4 r0, r1; const float rs = rs_of(lds, ssq, pm0, u.pm, row);
#pragma unroll
                        for (int e = 0; e < 4; ++e) { const float s0 = __builtin_amdgcn_rcpf(1.f + __expf(-acc[ai][bj][m][0][e] * rs)), s1 = __builtin_amdgcn_rcpf(1.f + __expf(-acc[ai][bj][m][1][e] * rs));
                            r0[e] = __builtin_amdgcn_logf(l0[e] + (1.f - l0[e]) * s0); r1[e] = __builtin_amdgcn_logf(l1[e] + (1.f - l1[e]) * s1); }
                        f16x8 hv; hv[0] = (_Float16)r0[0]; hv[1] = (_Float16)r0[1]; hv[2] = (_Float16)r0[2]; hv[3] = (_Float16)r0[3]; hv[4] = (_Float16)r1[0]; hv[5] = (_Float16)r1[1]; hv[6] = (_Float16)r1[2]; hv[7] = (_Float16)r1[3];
                        *(GAS f16x8*)((GAS _Float16*)LF + ((size_t)dir * S + row) * 256 + col) = hv; asm volatile("" ::: "memory"); } }
        } else {
            bf16_t* dst; int ld, cb; bool act = false;
            if (pn == 0) { dst = HQ; ld = 256; cb = 0; act = true; } else if (pn == 1) { dst = HV; ld = 256; cb = 0; } else if (pn == 4) { dst = HG; ld = 256; cb = 0; act = true; }
            else if (pn == 5) { dst = FU; ld = 256; cb = 0; } else { dst = AV; ld = 512; cb = (pn - 10) * 256; }
#pragma unroll
            for (int ai = 0; ai < 2; ++ai)
#pragma unroll
                for (int m = 0; m < 4; ++m) { const int row = row0 + ai * 128 + m * 16; bf16_t* rowp = dst + (size_t)row * ld + cb + c8; const float rs = rs_of(lds, ssq, pm0, u.pm, row);
#pragma unroll
                    for (int bj = 0; bj < 2; ++bj) { f32x4 v0 = acc[ai][bj][m][0] * rs, v1 = acc[ai][bj][m][1] * rs;
                        if (act) {
#pragma unroll
                            for (int e = 0; e < 4; ++e) { v0[e] = silu(v0[e]); v1[e] = silu(v1[e]); } }
                        u32x4 w; w.x = cvt_pk_bf16(v0[0], v0[1]); w.y = cvt_pk_bf16(v0[2], v0[3]); w.z = cvt_pk_bf16(v1[0], v1[1]); w.w = cvt_pk_bf16(v1[2], v1[3]);
                        *(GAS u32x4*)((GAS bf16_t*)rowp + bj * 128) = w; } }
        }
    }
};

__device__ __forceinline__ void make_tables(const Ctx& c, const P& p) {
    unsigned char* ws = p.ws;
    const int gt = c.bid * NTHR + c.tid, gs = c.G * NTHR;
    float* LB = (float*)(ws + OFF_LB);
    for (int e = gt; e < 512; e += gs) {
        float v[DEPTH], mx = -1e30f; for (int l = 0; l < DEPTH; ++l) { v[l] = p.lbs[l * 512 + e]; mx = fmaxf(mx, v[l]); }
        float sum = 0.f; for (int l = 0; l < DEPTH; ++l) { v[l] = expf(v[l] - mx); sum += v[l]; }
        float cum = 0.f; LB[e] = 0.f; for (int l = 1; l < DEPTH; ++l) { cum += v[l] / sum; LB[l * 512 + e] = cum; }
    }
    bf16_t* WC = (bf16_t*)(ws + OFF_W128C); bf16_t* WS_ = (bf16_t*)(ws + OFF_W128S);
    for (int e = gt; e < 16384; e += gs) { const int a = e >> 7, b = e & 127, idx = (a * b) & 127; const float x = (float)idx * (1.f / 64.f); WC[e] = f2bf(cospif(x)); WS_[e] = f2bf(sinpif(x)); }
    bf16_t* C64 = (bf16_t*)(ws + OFF_C64); bf16_t* S64 = (bf16_t*)(ws + OFF_S64);
    for (int e = gt; e < 4096; e += gs) { const int a = e >> 6, b = e & 63, idx = (a * b) & 63; const float x = (float)idx * (1.f / 32.f); C64[e] = f2bf(cospif(x)); S64[e] = f2bf(sinpif(x)); }
    float* TW = (float*)(ws + OFF_TW);
    for (int e = gt; e < 16384; e += gs) { const int a = e >> 7, b = e & 127, idx = a * b; const float x = (float)idx * (1.f / 8192.f); TW[2 * e] = cospif(x); TW[2 * e + 1] = sinpif(x); }
    float* CS = (float*)(ws + OFF_CS);
    for (int e = gt; e < S * 32; e += gs) { const int s = e >> 5, i = e & 31; const float invf = powf(10000.f, -(float)(2 * i) / 64.f); const float ang = (float)p.pos[s] * invf;
        double xr = (double)ang * 0.31830988618379067154; xr = xr - 2.0 * rint(xr * 0.5); const float xf = (float)xr; CS[2 * e] = cospif(xf); CS[2 * e + 1] = sinpif(xf); }
}
struct CvItem { const float* W; int K, N; bf16_t* WT; int k0, n0, drow0; const float* nw; };
__device__ __forceinline__ CvItem cv_decode(const P& p, int r, int n_in, int lin, int lrest) {
    constexpr int I_OUT = 16 * 32, I_UP = 16 * 128;
    CvItem it;
    if (r < n_in) { const int kb = r / 96, nb = r % 96; const int pn = nb >> 3; int drow = nb * 32;
        if (pn >= 6 && pn <= 9) { const int sb = nb & 7, head = sb >> 1, half = sb & 1; drow = pn * 256 + (4 * half + head) * 32; }
        it.W = p.w_in + (size_t)lin * D * NIN; it.K = D; it.N = NIN; it.WT = (bf16_t*)(p.ws + W_IN); it.k0 = kb * 64; it.n0 = nb * 32; it.drow0 = drow; it.nw = p.anw + lin * D; return it; }
    r -= n_in;
    if (r < I_OUT) { const int kb = r / 32, nb = r % 32; it.W = p.w_out + (size_t)lrest * D * D; it.K = D; it.N = D; it.WT = (bf16_t*)(p.ws + W_OUT); it.k0 = kb * 64; it.n0 = nb * 32; it.drow0 = nb * 32; it.nw = nullptr; return it; }
    r -= I_OUT;
    if (r < I_UP) { const int kb = r / 128, nb = r % 128; it.W = p.w_up + (size_t)lrest * D * FF; it.K = D; it.N = FF; it.WT = (bf16_t*)(p.ws + W_UP); it.k0 = kb * 64; it.n0 = nb * 32; it.drow0 = nb * 32; it.nw = p.mnw + lrest * D; return it; }
    r -= I_UP;
    { const int kb = r / 32, nb = r % 32; it.W = p.w_down + (size_t)lrest * FF * D; it.K = FF; it.N = D; it.WT = (bf16_t*)(p.ws + W_DOWN); it.k0 = kb * 64; it.n0 = nb * 32; it.drow0 = nb * 32; it.nw = nullptr; return it; }
}
__device__ __forceinline__ void cv_load(const CvItem& it, f32x4 (&v)[8], int lane) {
    const int cq = lane & 7, r8 = lane >> 3;
#pragma unroll
    for (int i = 0; i < 8; ++i) { const int kk = 8 * i + r8; v[i] = *(const GAS f32x4*)((const GAS float*)it.W + (size_t)(it.k0 + kk) * it.N + it.n0 + 4 * cq); if (it.nw) v[i] = v[i] * ((const GAS float*)it.nw)[it.k0 + kk]; }
}
__device__ __forceinline__ void cv_store(const CvItem& it, const f32x4 (&v)[8], LAS float* scr, int lane) {
    const int cq = lane & 7, r8 = lane >> 3;
#pragma unroll
    for (int i = 0; i < 8; ++i) { const int kk = 8 * i + r8; LAS float* d = scr + kk * 33 + 4 * cq; d[0] = v[i][0]; d[1] = v[i][1]; d[2] = v[i][2]; d[3] = v[i][3]; }
    LDS_WAIT();
    const int cc = lane & 7;
#pragma unroll
    for (int j = 0; j < 4; ++j) { const int n = (lane >> 3) + 8 * j; const LAS float* s = scr + (8 * cc) * 33 + n;
        u32x4 o; o.x = cvt_pk_bf16(s[0 * 33], s[1 * 33]); o.y = cvt_pk_bf16(s[2 * 33], s[3 * 33]); o.z = cvt_pk_bf16(s[4 * 33], s[5 * 33]); o.w = cvt_pk_bf16(s[6 * 33], s[7 * 33]);
        *(GAS u32x4*)((GAS bf16_t*)it.WT + (size_t)(it.drow0 + n) * it.K + it.k0 + 8 * cc) = o; }
    LDS_WAIT();
}
__device__ __forceinline__ void convert_weights(const Ctx& c, const P& p, int which, int lin, int lrest, int gw, int NGW) {
    LAS float* scr = (LAS float*)(c.lds + c.wave * 16384);
    constexpr int I_IN = 16 * 96, I_OUT = 16 * 32, I_UP = 16 * 128, I_DN = 64 * 32;
    const int n_in = (which & 1) ? I_IN : 0, n_rest = (which & 2) ? (I_OUT + I_UP + I_DN) : 0, ntot = n_in + n_rest;
    int r = gw; if (r >= ntot) return;
    CvItem cur = cv_decode(p, r, n_in, lin, lrest); f32x4 v[8]; cv_load(cur, v, c.lane);
    for (;;) {
        const int rn = r + NGW; const bool more = rn < ntot;
        CvItem nxt = cur; f32x4 vn[8];
        if (more) { nxt = cv_decode(p, rn, n_in, lin, lrest); cv_load(nxt, vn, c.lane); }
        cv_store(cur, v, scr, c.lane);
        if (!more) break;
#pragma unroll
        for (int i = 0; i < 8; ++i) v[i] = vn[i];
        cur = nxt; r = rn;
    }
}
__device__ __forceinline__ void x_to_bf16_ssq(const Ctx& c, const float* src, bf16_t* xnb, float* ssq) {
    const int gw = c.bid * 8 + c.wave, NGW = c.G * 8, lane = c.lane; const GAS float* sg = (const GAS float*)src;
    if (gw >= S) return;
    f32x4 v[4];
#pragma unroll
    for (int j = 0; j < 4; ++j) v[j] = ((const GAS f32x4*)(sg + (size_t)gw * D) + lane)[64 * j];
    for (int m = gw; m < S; m += NGW) {
        const int mn = (m + NGW < S) ? m + NGW : m; f32x4 vn[4];
#pragma unroll
        for (int j = 0; j < 4; ++j) vn[j] = ((const GAS f32x4*)(sg + (size_t)mn * D) + lane)[64 * j];
        float s = 0.f;
#pragma unroll
        for (int j = 0; j < 4; ++j) s += (v[j][0] * v[j][0] + v[j][1] * v[j][1]) + (v[j][2] * v[j][2] + v[j][3] * v[j][3]);
        s = wave_sum(s);
        GAS u32x2* o = (GAS u32x2*)((GAS bf16_t*)xnb + (size_t)m * D) + lane;
#pragma unroll
        for (int j = 0; j < 4; ++j) { u32x2 q; q.x = cvt_pk_bf16(v[j][0], v[j][1]); q.y = cvt_pk_bf16(v[j][2], v[j][3]); o[64 * j] = q; }
        if (lane < 16) ((GAS float*)ssq)[(size_t)m * 16 + lane] = (lane == 0) ? s : 0.f;
#pragma unroll
        for (int j = 0; j < 4; ++j) v[j] = vn[j];
    }
}
__device__ __forceinline__ void norm_rows(const Ctx& c, const float* src, const float* w, bf16_t* dst_bf, float* dst_f) {
    const int gw = c.bid * 8 + c.wave, NGW = c.G * 8, lane = c.lane;
    f32x4 w4[4];
#pragma unroll
    for (int j = 0; j < 4; ++j) w4[j] = ((const f32x4*)w)[lane + 64 * j];
    for (int m = gw; m < S; m += NGW) {
        const f32x4* xr = (const f32x4*)(src + (size_t)m * D) + lane; f32x4 v[4]; float s = 0.f;
#pragma unroll
        for (int j = 0; j < 4; ++j) { v[j] = xr[64 * j]; s += (v[j][0] * v[j][0] + v[j][1] * v[j][1]) + (v[j][2] * v[j][2] + v[j][3] * v[j][3]); }
        const float rs = 1.f / sqrtf(wave_sum(s) * (1.f / D) + 1e-6f);
        if (dst_bf) { u32x2* o = (u32x2*)(dst_bf + (size_t)m * D) + lane;
#pragma unroll
            for (int j = 0; j < 4; ++j) { u32x2 q; q.x = cvt_pk_bf16(v[j][0] * rs * w4[j][0], v[j][1] * rs * w4[j][1]); q.y = cvt_pk_bf16(v[j][2] * rs * w4[j][2], v[j][3] * rs * w4[j][3]); o[64 * j] = q; } }
        else { f32x4* o = (f32x4*)(dst_f + (size_t)m * D) + lane;
#pragma unroll
            for (int j = 0; j < 4; ++j) o[64 * j] = v[j] * rs * w4[j]; }
    }
}

__device__ __forceinline__ void final_norm(const Ctx& c, const bf16_t* xnb, const float* ssq, const float* w, float* out) {
    const int gw = c.bid * 8 + c.wave, NGW = c.G * 8, lane = c.lane;
    if (gw >= S) return;
    f32x4 w4[4];
#pragma unroll
    for (int j = 0; j < 4; ++j) w4[j] = ((const GAS f32x4*)(const GAS float*)w)[4 * lane + j];
    const GAS bf16_t* xg = (const GAS bf16_t*)xnb; const GAS float* sg = (const GAS float*)ssq;
    u32x4 a = ((const GAS u32x4*)(xg + (size_t)gw * D) + 2 * lane)[0], b = ((const GAS u32x4*)(xg + (size_t)gw * D) + 2 * lane)[1];
    f32x4 q0 = ((const GAS f32x4*)(sg + (size_t)gw * 16))[0], q1 = ((const GAS f32x4*)(sg + (size_t)gw * 16))[1], q2 = ((const GAS f32x4*)(sg + (size_t)gw * 16))[2], q3 = ((const GAS f32x4*)(sg + (size_t)gw * 16))[3];
    for (int m = gw; m < S; m += NGW) {
        const int mn = (m + NGW < S) ? m + NGW : m;
        const u32x4 an = ((const GAS u32x4*)(xg + (size_t)mn * D) + 2 * lane)[0], bn = ((const GAS u32x4*)(xg + (size_t)mn * D) + 2 * lane)[1];
        const f32x4 n0 = ((const GAS f32x4*)(sg + (size_t)mn * 16))[0], n1 = ((const GAS f32x4*)(sg + (size_t)mn * 16))[1], n2 = ((const GAS f32x4*)(sg + (size_t)mn * 16))[2], n3 = ((const GAS f32x4*)(sg + (size_t)mn * 16))[3];
        const float ssum = (((q0[0] + q0[1]) + (q0[2] + q0[3])) + ((q1[0] + q1[1]) + (q1[2] + q1[3]))) + (((q2[0] + q2[1]) + (q2[2] + q2[3])) + ((q3[0] + q3[1]) + (q3[2] + q3[3])));
        const float rs = 1.f / sqrtf(ssum * (1.f / D) + 1e-6f);
        GAS f32x4* o = (GAS f32x4*)((GAS float*)out + (size_t)m * D) + 4 * lane;
        o[0] = (f32x4){__uint_as_float(a.x << 16), __uint_as_float(a.x & 0xffff0000u), __uint_as_float(a.y << 16), __uint_as_float(a.y & 0xffff0000u)} * rs * w4[0];
        o[1] = (f32x4){__uint_as_float(a.z << 16), __uint_as_float(a.z & 0xffff0000u), __uint_as_float(a.w << 16), __uint_as_float(a.w & 0xffff0000u)} * rs * w4[1];
        o[2] = (f32x4){__uint_as_float(b.x << 16), __uint_as_float(b.x & 0xffff0000u), __uint_as_float(b.y << 16), __uint_as_float(b.y & 0xffff0000u)} * rs * w4[2];
        o[3] = (f32x4){__uint_as_float(b.z << 16), __uint_as_float(b.z & 0xffff0000u), __uint_as_float(b.w << 16), __uint_as_float(b.w & 0xffff0000u)} * rs * w4[3];
        a = an; b = bn; q0 = n0; q1 = n1; q2 = n2; q3 = n3;
    }
}
typedef short s16x4 __attribute__((ext_vector_type(4)));
constexpr int VS_PITCH = 144;
template <int OFF> __device__ __forceinline__ s16x4 tr_read(unsigned vb) { s16x4 r; asm volatile("ds_read_b64_tr_b16 %0, %1 offset:%2" : "=&v"(r) : "v"(vb), "i"(OFF) : "memory"); return r; }
__device__ __forceinline__ void hgrn_passA(const Ctx& c, const _Float16* LF, const bf16_t* HV, float* UT, float* DEC) {
    const int h = c.wave >> 1, dir = c.wave & 1, lane = c.lane, fr = lane & 15, fq = lane >> 4;
    LAS bf16_t* KlT = (LAS bf16_t*)(c.lds + c.wave * 9216);
    LAS bf16_t* VT = (LAS bf16_t*)(c.lds + 8 * 9216 + h * 9216);
    for (int n = c.bid; n < 256; n += c.G) {
        const GAS _Float16* lfp = (const GAS _Float16*)LF + ((size_t)dir * S + n * 64) * 256 + h * 64 + lane;
        float lf[64];
#pragma unroll
        for (int t = 0; t < 64; ++t) lf[t] = (float)lfp[(size_t)t * 256];
        float run = 1.f;
        if (dir == 0) {
#pragma unroll
            for (int s = 63; s >= 0; --s) { const float f = __builtin_amdgcn_exp2f(lf[s]); lf[s] = (1.f - f) * run; run *= f; }
        } else {
#pragma unroll
            for (int s = 0; s < 64; ++s) { const float f = __builtin_amdgcn_exp2f(lf[s]); lf[s] = (1.f - f) * run; run *= f; }
        }
#pragma unroll
        for (int i = 0; i < 8; ++i) { u32x4 w; w.x = cvt_pk_bf16(lf[8 * i], lf[8 * i + 1]); w.y = cvt_pk_bf16(lf[8 * i + 2], lf[8 * i + 3]); w.z = cvt_pk_bf16(lf[8 * i + 4], lf[8 * i + 5]); w.w = cvt_pk_bf16(lf[8 * i + 6], lf[8 * i + 7]);
            *(LAS u32x4*)(KlT + lane * 72 + 8 * i) = w; }
        ((GAS float*)DEC)[((size_t)(n * 2 + dir) * 4 + h) * 64 + lane] = run;
        { const GAS bf16_t* vp = (const GAS bf16_t*)HV + (size_t)(n * 64 + 32 * dir) * 256 + h * 64; u32x4 vw[4];
#pragma unroll
            for (int i = 0; i < 4; ++i) { const int ci = i * 64 + lane; vw[i] = *(const GAS u32x4*)(vp + (size_t)(ci >> 3) * 256 + 8 * (ci & 7)); }
#pragma unroll
            for (int i = 0; i < 4; ++i) { const int ci = i * 64 + lane; *(LAS u32x4*)(VT + (32 * dir + (ci >> 3)) * 72 + 8 * (ci & 7)) = vw[i]; } }
        __syncthreads();
        f32x4 acc[4][4];
#pragma unroll
        for (int a = 0; a < 4; ++a)
#pragma unroll
            for (int b = 0; b < 4; ++b) acc[a][b] = (f32x4){0.f, 0.f, 0.f, 0.f};
        { const unsigned vbp = (unsigned)(size_t)((LAS unsigned char*)VT + (8 * fq + (fr >> 2)) * 144 + 8 * (fr & 3));
#define PA_KSTEP(KK) do { const s16x4 l0 = tr_read<(KK) * 4608>(vbp), h0 = tr_read<(KK) * 4608 + 576>(vbp), l1 = tr_read<(KK) * 4608 + 32>(vbp), h1 = tr_read<(KK) * 4608 + 576 + 32>(vbp); \
            const s16x4 l2 = tr_read<(KK) * 4608 + 64>(vbp), h2 = tr_read<(KK) * 4608 + 576 + 64>(vbp), l3 = tr_read<(KK) * 4608 + 96>(vbp), h3 = tr_read<(KK) * 4608 + 576 + 96>(vbp); \
            bf16x8 b[4]; _Pragma("unroll") for (int t = 0; t < 4; ++t) b[t] = *(const LAS bf16x8*)(KlT + (16 * t + fr) * 72 + 32 * (KK) + 8 * fq); \
            asm volatile("s_waitcnt lgkmcnt(0)" ::: "memory"); __builtin_amdgcn_sched_barrier(0); \
            bf16x8 a[4]; a[0] = (bf16x8){l0[0], l0[1], l0[2], l0[3], h0[0], h0[1], h0[2], h0[3]}; a[1] = (bf16x8){l1[0], l1[1], l1[2], l1[3], h1[0], h1[1], h1[2], h1[3]}; \
            a[2] = (bf16x8){l2[0], l2[1], l2[2], l2[3], h2[0], h2[1], h2[2], h2[3]}; a[3] = (bf16x8){l3[0], l3[1], l3[2], l3[3], h3[0], h3[1], h3[2], h3[3]}; \
            _Pragma("unroll") for (int mt = 0; mt < 4; ++mt) _Pragma("unroll") for (int nt = 0; nt < 4; ++nt) acc[mt][nt] = mfma16(b[nt], a[mt], acc[mt][nt]); __builtin_amdgcn_sched_barrier(0); } while (0)
            PA_KSTEP(0); PA_KSTEP(1);
#undef PA_KSTEP
        }
        int lo_ = fr * 64 + 4 * fq; asm volatile("" : "+v"(lo_));
        GAS float* up = (GAS float*)UT + ((size_t)(n * 2 + dir) * 4 + h) * 4096 + lo_;
#pragma unroll
        for (int mt = 0; mt < 4; ++mt)
#pragma unroll
            for (int nt = 0; nt < 4; ++nt) *(GAS f32x4*)(up + (16 * mt) * 64 + 16 * nt) = acc[mt][nt];
        __syncthreads();
    }
}
__device__ __forceinline__ void hgrn_scan(int sb, int tid, const float* UT, const float* DEC, bf16_t* SS) {
    const int dir = sb >> 5, hk0 = (sb & 31) * 512, h = hk0 >> 12, k = tid & 63;
    const GAS float* ub = (const GAS float*)UT + (size_t)dir * 16384 + hk0; const GAS float* db = (const GAS float*)DEC + (size_t)(dir * 4 + h) * 64; GAS bf16_t* sbp = (GAS bf16_t*)SS + (size_t)dir * 16384 + hk0;
    float st = 0.f;
    for (int n0 = 0; n0 < 256; n0 += 64) {
        float u[64], d[64];
#pragma unroll
        for (int i = 0; i < 64; ++i) { const int n = dir ? (255 - n0 - i) : (n0 + i); u[i] = (ub + (size_t)n * 32768)[tid]; d[i] = (db + (size_t)n * 512)[k]; }
#pragma unroll
        for (int i = 0; i < 64; ++i) { const int n = dir ? (255 - n0 - i) : (n0 + i); (sbp + (size_t)n * 32768)[tid] = f2bf(st); st = d[i] * st + u[i]; }
    }
}
__device__ __forceinline__ void hgrn_passC(const Ctx& c, const _Float16* LF, const bf16_t* HQ, const bf16_t* HV, const bf16_t* HG, const bf16_t* SS, bf16_t* MIXED) {
    const int h = c.wave >> 1, dir = c.wave & 1, lane = c.lane, fr = lane & 15, fq = lane >> 4;
    LAS bf16_t* bA = (LAS bf16_t*)(c.lds + c.wave * 18432);
    LAS bf16_t* bB = bA + 64 * 72;
    for (int n = c.bid; n < 256; n += c.G) {
        const GAS _Float16* lfp = (const GAS _Float16*)LF + ((size_t)dir * S + n * 64) * 256 + h * 64 + lane;
        const GAS bf16_t* qp = (const GAS bf16_t*)HQ + (size_t)(n * 64) * 256 + h * 64 + lane;
        float b[64]; unsigned qi[32];
#pragma unroll
        for (int t = 0; t < 64; ++t) b[t] = (float)lfp[(size_t)t * 256];
        u32x4 sreg[8];
        { const GAS bf16_t* sp = (const GAS bf16_t*)SS + ((size_t)(n * 2 + dir) * 4 + h) * 4096;
#pragma unroll
            for (int i = 0; i < 8; ++i) sreg[i] = *(const GAS u32x4*)(sp + (i * 64 + lane) * 8); }
        if (dir == 0) {
#pragma unroll
            for (int t = 1; t < 64; ++t) b[t] += b[t - 1];
        } else {
#pragma unroll
            for (int t = 62; t >= 0; --t) b[t] += b[t + 1];
        }
        const float ref = dir == 0 ? b[31] : b[32]; const float eref = __builtin_amdgcn_exp2f(ref);
#pragma unroll
        for (int t2 = 0; t2 < 32; ++t2) { float qiv[2];
#pragma unroll
            for (int o = 0; o < 2; ++o) { const int t = 2 * t2 + o;
                float prev; if (dir == 0) prev = (t == 0) ? 0.f : b[t - 1]; else prev = (t == 63) ? 0.f : b[t + 1];
                const float lf = b[t] - prev; const float kv = 1.f - __builtin_amdgcn_exp2f(lf); const float q = bf2f(qp[(size_t)t * 256]);
                const float qe = q * __builtin_amdgcn_exp2f(fminf(b[t] - ref, 115.f)), ke = kv * __builtin_amdgcn_exp2f(fminf(ref - b[t], 115.f)); qiv[o] = qe * eref;
                bA[t * 72 + lane] = f2bf(qe); bB[t * 72 + lane] = f2bf(ke); }
            qi[t2] = cvt_pk_bf16(qiv[0], qiv[1]); }
        LDS_WAIT();
        f32x4 sc[4][4];
#pragma unroll
        for (int a = 0; a < 4; ++a)
#pragma unroll
            for (int bb = 0; bb < 4; ++bb) sc[a][bb] = (f32x4){0.f, 0.f, 0.f, 0.f};
#pragma unroll
        for (int kk = 0; kk < 2; ++kk) { bf16x8 a[4], bq[4];
#pragma unroll
            for (int t = 0; t < 4; ++t) { a[t] = *(const LAS bf16x8*)(bA + (16 * t + fr) * 72 + 32 * kk + 8 * fq); bq[t] = *(const LAS bf16x8*)(bB + (16 * t + fr) * 72 + 32 * kk + 8 * fq); }
#pragma unroll
            for (int mt = 0; mt < 4; ++mt)
#pragma unroll
                for (int nt = 0; nt < 4; ++nt) sc[nt][mt] = mfma16(bq[nt], a[mt], sc[nt][mt]); }
        LDS_WAIT();
        bf16x8 pb[4][2];
#pragma unroll
        for (int mt = 0; mt < 4; ++mt)
#pragma unroll
            for (int kk = 0; kk < 2; ++kk) { float pv[8];
#pragma unroll
                for (int hh = 0; hh < 2; ++hh)
#pragma unroll
                    for (int j = 0; j < 4; ++j) { const int nt = 2 * kk + hh; const int s = 16 * nt + 4 * fq + j, t = 16 * mt + fr; const bool ok = dir == 0 ? (s <= t) : (s >= t); pv[4 * hh + j] = ok ? sc[nt][mt][j] : 0.f; }
                u32x4 pw; pw.x = cvt_pk_bf16(pv[0], pv[1]); pw.y = cvt_pk_bf16(pv[2], pv[3]); pw.z = cvt_pk_bf16(pv[4], pv[5]); pw.w = cvt_pk_bf16(pv[6], pv[7]);
                __builtin_memcpy(&pb[mt][kk], &pw, 16); }
        { const GAS bf16_t* vp = (const GAS bf16_t*)HV + (size_t)(n * 64) * 256 + h * 64; u32x4 vw[8];
#pragma unroll
            for (int i = 0; i < 8; ++i) { const int ci = i * 64 + lane; vw[i] = *(const GAS u32x4*)(vp + (size_t)(ci >> 3) * 256 + 8 * (ci & 7)); }
#pragma unroll
            for (int i = 0; i < 8; ++i) { const int ci = i * 64 + lane; *(LAS u32x4*)(bB + (ci >> 3) * 72 + 8 * (ci & 7)) = vw[i]; } }
        LDS_WAIT();
        f32x4 o[4][4];
#pragma unroll
        for (int a = 0; a < 4; ++a)
#pragma unroll
            for (int bb = 0; bb < 4; ++bb) o[a][bb] = (f32x4){0.f, 0.f, 0.f, 0.f};
        { const unsigned vbv = (unsigned)(size_t)((LAS unsigned char*)bB + (4 * fq + (fr >> 2)) * 144 + 8 * (fr & 3));
#define PC_KSTEP(KK) do { const s16x4 l0 = tr_read<(KK) * 4608>(vbv), h0 = tr_read<(KK) * 4608 + 2304>(vbv), l1 = tr_read<(KK) * 4608 + 32>(vbv), h1 = tr_read<(KK) * 4608 + 2304 + 32>(vbv); \
            const s16x4 l2 = tr_read<(KK) * 4608 + 64>(vbv), h2 = tr_read<(KK) * 4608 + 2304 + 64>(vbv), l3 = tr_read<(KK) * 4608 + 96>(vbv), h3 = tr_read<(KK) * 4608 + 2304 + 96>(vbv); \
            asm volatile("s_waitcnt lgkmcnt(0)" ::: "memory"); __builtin_amdgcn_sched_barrier(0); \
            bf16x8 bq[4]; bq[0] = (bf16x8){l0[0], l0[1], l0[2], l0[3], h0[0], h0[1], h0[2], h0[3]}; bq[1] = (bf16x8){l1[0], l1[1], l1[2], l1[3], h1[0], h1[1], h1[2], h1[3]}; \
            bq[2] = (bf16x8){l2[0], l2[1], l2[2], l2[3], h2[0], h2[1], h2[2], h2[3]}; bq[3] = (bf16x8){l3[0], l3[1], l3[2], l3[3], h3[0], h3[1], h3[2], h3[3]}; \
            _Pragma("unroll") for (int mt = 0; mt < 4; ++mt) _Pragma("unroll") for (int nt = 0; nt < 4; ++nt) o[mt][nt] = mfma16(bq[nt], pb[mt][KK], o[mt][nt]); } while (0)
            PC_KSTEP(0); PC_KSTEP(1);
#undef PC_KSTEP
        }
        LDS_WAIT();
#pragma unroll
        for (int t2 = 0; t2 < 32; ++t2) { bA[(2 * t2) * 72 + lane] = (bf16_t)(qi[t2] & 0xffffu); bA[(2 * t2 + 1) * 72 + lane] = (bf16_t)(qi[t2] >> 16); }
#pragma unroll
        for (int i = 0; i < 8; ++i) { const int ci = i * 64 + lane; *(LAS u32x4*)(bB + (ci >> 3) * 72 + 8 * (ci & 7)) = sreg[i]; }
        LDS_WAIT();
#pragma unroll
        for (int kk = 0; kk < 2; ++kk) { bf16x8 a[4], bq[4];
#pragma unroll
            for (int t = 0; t < 4; ++t) { a[t] = *(const LAS bf16x8*)(bA + (16 * t + fr) * 72 + 32 * kk + 8 * fq); bq[t] = *(const LAS bf16x8*)(bB + (16 * t + fr) * 72 + 32 * kk + 8 * fq); }
#pragma unroll
            for (int mt = 0; mt < 4; ++mt)
#pragma unroll
                for (int nt = 0; nt < 4; ++nt) o[mt][nt] = mfma16(bq[nt], a[mt], o[mt][nt]); }
        LDS_WAIT();
        LAS float* ox = (LAS float*)bA;
        if (dir == 1) {
#pragma unroll
            for (int mt = 0; mt < 4; ++mt)
#pragma unroll
                for (int nt = 0; nt < 4; ++nt) *(LAS f32x4*)(ox + (16 * mt + fr) * 72 + 16 * nt + 4 * fq) = o[mt][nt];
        }
        __syncthreads();
        if (dir == 0) {
            const LAS float* px = (const LAS float*)(c.lds + (c.wave + 1) * 18432);
#pragma unroll
            for (int mt = 0; mt < 4; ++mt) { const int t = 16 * mt + fr; float ss = 0.f;
#pragma unroll
                for (int nt = 0; nt < 4; ++nt) { const f32x4 v = o[mt][nt] + *(const LAS f32x4*)(px + t * 72 + 16 * nt + 4 * fq); o[mt][nt] = v; ss += (v[0] * v[0] + v[1] * v[1]) + (v[2] * v[2] + v[3] * v[3]); }
                ss += __shfl_xor(ss, 16); ss += __shfl_xor(ss, 32);
                const float rs = 1.f / sqrtf(ss * (1.f / 64.f) + 1e-6f);
                const size_t ro = (size_t)(n * 64 + t);
#pragma unroll
                for (int nt = 0; nt < 4; ++nt) { const int col = h * 64 + 16 * nt + 4 * fq; const u32x2 g2 = *(const GAS u32x2*)((const GAS bf16_t*)HG + ro * 256 + col);
                    const float g0 = __uint_as_float(g2.x << 16), g1 = __uint_as_float(g2.x & 0xffff0000u), g2f = __uint_as_float(g2.y << 16), g3 = __uint_as_float(g2.y & 0xffff0000u);
                    u32x2 wv; wv.x = cvt_pk_bf16(o[mt][nt][0] * rs * g0, o[mt][nt][1] * rs * g1); wv.y = cvt_pk_bf16(o[mt][nt][2] * rs * g2f, o[mt][nt][3] * rs * g3);
                    *(GAS u32x2*)((GAS bf16_t*)MIXED + ro * 1024 + col) = wv; } }
        }
        __syncthreads();
    }
}

template <int I> __device__ __forceinline__ void pv_step(f32x4 (&o)[4], unsigned vb, bf16x8 pa) {
    constexpr int B = I * 32 * VS_PITCH, H = 16 * VS_PITCH;
    const s16x4 l0 = tr_read<B>(vb), l1 = tr_read<B + 32>(vb), l2 = tr_read<B + 64>(vb), l3 = tr_read<B + 96>(vb);
    s16x4 h0 = (s16x4){0, 0, 0, 0}, h1 = h0, h2 = h0, h3 = h0;
    if constexpr (I < 4) { h0 = tr_read<B + H>(vb); h1 = tr_read<B + H + 32>(vb); h2 = tr_read<B + H + 64>(vb); h3 = tr_read<B + H + 96>(vb); }
    asm volatile("s_waitcnt lgkmcnt(0)" ::: "memory"); __builtin_amdgcn_sched_barrier(0);
#define PKV(L, Hh) (bf16x8){L[0], L[1], L[2], L[3], Hh[0], Hh[1], Hh[2], Hh[3]}
    o[0] = mfma16(PKV(l0, h0), pa, o[0]); o[1] = mfma16(PKV(l1, h1), pa, o[1]); o[2] = mfma16(PKV(l2, h2), pa, o[2]); o[3] = mfma16(PKV(l3, h3), pa, o[3]);
#undef PKV
}
__device__ __forceinline__ void attn_phase(const Ctx& c, const bf16_t* AQ, const bf16_t* AK, const bf16_t* AV, bf16_t* OP, float* LSE) {
    const int tid = c.tid, lane = c.lane, w = c.wave, fr = lane & 15, fq = lane >> 4;
    const GAS bf16_t* AQg = (const GAS bf16_t*)AQ; const GAS bf16_t* AKg = (const GAS bf16_t*)AK; const GAS bf16_t* AVg = (const GAS bf16_t*)AV; GAS bf16_t* OPg = (GAS bf16_t*)OP; GAS float* LSEg = (GAS float*)LSE;
    u32x4 kreg[4], vreg[4]; bf16x8 qreg[2];
#define ATT_LOAD(IT) do { const int p_ = (IT) >> 10, rem_ = (IT) & 1023, h_ = rem_ >> 7, gi_ = rem_ & 127; const int dsh_ = 2 * p_, Lp_ = S >> dsh_, ngs_ = 7 - dsh_; \
        const int r_ = gi_ >> ngs_, Jb_ = (gi_ & ((1 << ngs_) - 1)) * 128; \
        _Pragma("unroll") for (int ps = 0; ps < 4; ++ps) { const int kl = ps * 64 + (tid >> 3), ch = tid & 7; const int J = Jb_ - 64 + kl; const bool ok = (J >= 0) && (J < Lp_); \
            kreg[ps] = (u32x4){0u, 0u, 0u, 0u}; vreg[ps] = (u32x4){0u, 0u, 0u, 0u}; \
            if (ok) { const size_t off = ((size_t)((J << dsh_) + r_)) * 512 + h_ * 64 + 8 * ch; kreg[ps] = *(const GAS u32x4*)(AKg + off); vreg[ps] = *(const GAS u32x4*)(AVg + off); } } \
        { const size_t qo = ((size_t)(((Jb_ + 16 * w + fr) << dsh_) + r_)) * 512 + h_ * 64 + 8 * fq; qreg[0] = *(const GAS bf16x8*)(AQg + qo); qreg[1] = *(const GAS bf16x8*)(AQg + qo + 32); } } while (0)
    const bool xmap = (c.G == 256); const int nk = xmap ? 12 : (3072 - c.bid + c.G - 1) / c.G;
#define ATT_ITEM(K) (xmap ? (((K) >> 2) * 1024 + (c.bid & 7) * 128 + ((K) & 3) * 32 + (c.bid >> 3)) : (c.bid + (K) * c.G))
    if (nk > 0) { const int it0 = ATT_ITEM(0); ATT_LOAD(it0); }
    for (int kq = 0; kq < nk; ++kq) {
        const int it = ATT_ITEM(kq);
        LAS bf16_t* Ks = (LAS bf16_t*)(c.lds + (kq & 1) * 73728);
        LAS bf16_t* Vt = (LAS bf16_t*)(c.lds + (kq & 1) * 73728 + 36864);
        const int p = it >> 10, rem = it & 1023, h = rem >> 7, gi = rem & 127;
        const int dsh = 2 * p, Lp = S >> dsh, ngs = 7 - dsh;
        const int r = gi >> ngs, Jb = (gi & ((1 << ngs) - 1)) * 128;
#pragma unroll
        for (int ps = 0; ps < 4; ++ps) { const int kl = ps * 64 + (tid >> 3), ch = tid & 7; const u32x4 vv = vreg[ps];
            *(LAS u32x4*)(Ks + kl * 72 + 8 * ch) = kreg[ps];
            *(LAS u32x4*)((LAS unsigned char*)Vt + kl * VS_PITCH + 16 * ch) = vv; }
        bf16x8 qf[2]; qf[0] = qreg[0]; qf[1] = qreg[1];
        __syncthreads();
        if (kq + 1 < nk) { const int nit = ATT_ITEM(kq + 1); ATT_LOAD(nit); }
        const int J0 = Jb + 16 * w, kb = 16 * w;
        f32x4 st[9];
#pragma unroll
        for (int tt = 0; tt < 9; ++tt) { st[tt] = (f32x4){0.f, 0.f, 0.f, 0.f};
#pragma unroll
            for (int kk = 0; kk < 2; ++kk) { const bf16x8 a = *(const LAS bf16x8*)(Ks + (kb + 16 * tt + fr) * 72 + 32 * kk + 8 * fq); st[tt] = mfma16(a, qf[kk], st[tt]); } }
#pragma unroll
        for (int j = 0; j < 4; ++j) { if (4 * fq + j < fr) st[0][j] = -1e30f; if (4 * fq + j > fr) st[8][j] = -1e30f; }
        if (Jb == 0 || Jb + 128 == Lp) {
#pragma unroll
            for (int tt = 0; tt < 9; ++tt)
#pragma unroll
                for (int j = 0; j < 4; ++j) { const int Jk = J0 - 64 + 16 * tt + 4 * fq + j; if ((unsigned)Jk >= (unsigned)Lp) st[tt][j] = -1e30f; } }
        float mx = -1e30f;
#pragma unroll
        for (int tt = 0; tt < 9; ++tt) mx = fmaxf(mx, fmaxf(fmaxf(st[tt][0], st[tt][1]), fmaxf(st[tt][2], st[tt][3])));
        mx = fmaxf(mx, __shfl_xor(mx, 16)); mx = fmaxf(mx, __shfl_xor(mx, 32));
        float ls = 0.f;
#pragma unroll
        for (int tt = 0; tt < 9; ++tt)
#pragma unroll
            for (int j = 0; j < 4; ++j) { const float pv = __builtin_amdgcn_exp2f(st[tt][j] - mx); st[tt][j] = pv; ls += pv; }
        ls += __shfl_xor(ls, 16); ls += __shfl_xor(ls, 32);
        f32x4 o[4];
#pragma unroll
        for (int nt = 0; nt < 4; ++nt) o[nt] = (f32x4){0.f, 0.f, 0.f, 0.f};
        bf16x8 pa[5];
#pragma unroll
        for (int i = 0; i < 5; ++i) { u32x4 pw; pw.x = cvt_pk_bf16(st[2 * i][0], st[2 * i][1]); pw.y = cvt_pk_bf16(st[2 * i][2], st[2 * i][3]);
            if (i < 4) { pw.z = cvt_pk_bf16(st[2 * i + 1][0], st[2 * i + 1][1]); pw.w = cvt_pk_bf16(st[2 * i + 1][2], st[2 * i + 1][3]); } else { pw.z = 0u; pw.w = 0u; }
            __builtin_memcpy(&pa[i], &pw, 16); }
        { const unsigned vb = (unsigned)(size_t)((LAS unsigned char*)Vt + (kb + 4 * fq + (fr >> 2)) * VS_PITCH + 8 * (fr & 3));
            pv_step<0>(o, vb, pa[0]); pv_step<1>(o, vb, pa[1]); pv_step<2>(o, vb, pa[2]); pv_step<3>(o, vb, pa[3]); pv_step<4>(o, vb, pa[4]); }
        const float linv = 1.f / ls; const size_t qpos = (size_t)(((J0 + fr) << dsh) + r);
#pragma unroll
        for (int nt = 0; nt < 4; ++nt) { u32x2 wv; wv.x = cvt_pk_bf16(o[nt][0] * linv, o[nt][1] * linv); wv.y = cvt_pk_bf16(o[nt][2] * linv, o[nt][3] * linv);
            *(GAS u32x2*)(OPg + ((size_t)p * S + qpos) * 512 + h * 64 + 16 * nt + 4 * fq) = wv; }
        if (fq == 0) LSEg[((size_t)p * S + qpos) * 8 + h] = mx + __builtin_amdgcn_logf(ls);
    }
    __syncthreads();
#undef ATT_LOAD
#undef ATT_ITEM
}
constexpr int CMB_SPLIT = 7168 * 64;
__device__ __forceinline__ void attn_combine(const bf16_t* OP, const float* LSE, bf16_t* MIXED, int e0, int e1, int wid, int nw, int tid) {
    const GAS float* LSg = (const GAS float*)LSE; const GAS bf16_t* OPg = (const GAS bf16_t*)OP; GAS bf16_t* MXg = (GAS bf16_t*)MIXED;
    const int stride = nw * NTHR;
    for (int eb = e0 + wid * NTHR + tid; eb < e1; eb += 4 * stride) {
        float l[4][3]; u32x4 av[4][3]; bool ok[4];
#pragma unroll
        for (int q = 0; q < 4; ++q) { const int e = eb + q * stride; ok[q] = e < e1; const int ee = ok[q] ? e : eb; const int s = ee >> 6, h = (ee >> 3) & 7, ch = ee & 7; const size_t off = (size_t)s * 512 + h * 64 + 8 * ch;
#pragma unroll
            for (int pp = 0; pp < 3; ++pp) { l[q][pp] = LSg[((size_t)pp * S + s) * 8 + h]; av[q][pp] = *(const GAS u32x4*)(OPg + (size_t)pp * S * 512 + off); } }
#pragma unroll
        for (int q = 0; q < 4; ++q) { const int e = eb + q * stride; const int s = e >> 6, h = (e >> 3) & 7, ch = e & 7;
            float l0 = l[q][0], l1 = l[q][1], l2 = l[q][2];
            const float m = fmaxf(l0, fmaxf(l1, l2)); l0 = __builtin_amdgcn_exp2f(l0 - m); l1 = __builtin_amdgcn_exp2f(l1 - m); l2 = __builtin_amdgcn_exp2f(l2 - m); const float inv = 1.f / (l0 + l1 + l2); l0 *= inv; l1 *= inv; l2 *= inv;
            const u32x4 a = av[q][0], b2 = av[q][1], cc = av[q][2]; u32x4 o;
#pragma unroll
            for (int i = 0; i < 4; ++i) { const float lo = l0 * __uint_as_float(a[i] << 16) + l1 * __uint_as_float(b2[i] << 16) + l2 * __uint_as_float(cc[i] << 16);
                const float hi = l0 * __uint_as_float(a[i] & 0xffff0000u) + l1 * __uint_as_float(b2[i] & 0xffff0000u) + l2 * __uint_as_float(cc[i] & 0xffff0000u); o[i] = cvt_pk_bf16(lo, hi); }
            if (ok[q]) *(GAS u32x4*)(MXg + (size_t)s * 1024 + 512 + h * 64 + 8 * ch) = o; }
    }
}

__device__ __forceinline__ void fft_f1(const Ctx& c, const bf16_t* FU, const bf16_t* WC, const bf16_t* WSn, const float* TW, bf16_t* TP) {
    const int tid = c.tid, lane = c.lane, w = c.wave, fr = lane & 15, fq = lane >> 4;
    LAS bf16_t* UT2 = (LAS bf16_t*)c.lds;
    LAS bf16_t* OB = (LAS bf16_t*)(c.lds + 34816);
    LAS bf16_t* TC = (LAS bf16_t*)(c.lds + 102400);
    LAS float* TWr = (LAS float*)(c.lds + 137216);
    LAS bf16_t* TS = OB;
    const GAS bf16_t* WCg = (const GAS bf16_t*)WC; const GAS bf16_t* WSg = (const GAS bf16_t*)WSn; const GAS bf16_t* FUg = (const GAS bf16_t*)FU;
    for (int it = c.bid; it < 256; it += c.G) {
        const int s2 = it >> 1, half = it & 1;
#pragma unroll
        for (int i = 0; i < 4; ++i) { const int ci = i * 512 + tid, row = ci >> 4, ch = ci & 15; *(LAS u32x4*)(TC + row * 136 + 8 * ch) = *(const GAS u32x4*)(WCg + row * 128 + 8 * ch); *(LAS u32x4*)(TS + row * 136 + 8 * ch) = *(const GAS u32x4*)(WSg + row * 128 + 8 * ch); }
        if (tid < 128) { const f32x2 t2 = *(const GAS f32x2*)((const GAS float*)TW + 2 * (s2 * 128 + tid)); TWr[2 * tid] = t2[0]; TWr[2 * tid + 1] = t2[1]; }
#pragma unroll
        for (int ps = 0; ps < 4; ++ps) { const int s1 = ps * 32 + (tid >> 4), ch = tid & 15;
            const u32x4 v = *(const GAS u32x4*)(FUg + (size_t)(128 * s1 + s2) * 256 + half * 128 + 8 * ch);
            LAS bf16_t* dp = UT2 + (8 * ch) * 136 + s1;
            dp[0 * 136] = (bf16_t)(v.x & 0xffffu); dp[1 * 136] = (bf16_t)(v.x >> 16); dp[2 * 136] = (bf16_t)(v.y & 0xffffu); dp[3 * 136] = (bf16_t)(v.y >> 16);
            dp[4 * 136] = (bf16_t)(v.z & 0xffffu); dp[5 * 136] = (bf16_t)(v.z >> 16); dp[6 * 136] = (bf16_t)(v.w & 0xffffu); dp[7 * 136] = (bf16_t)(v.w >> 16); }
        __syncthreads();
        f32x4 re[8], im[8];
#pragma unroll
        for (int mt = 0; mt < 8; ++mt) { re[mt] = (f32x4){0.f, 0.f, 0.f, 0.f}; im[mt] = (f32x4){0.f, 0.f, 0.f, 0.f}; }
#pragma unroll
        for (int kk = 0; kk < 4; ++kk) { const bf16x8 b = *(const LAS bf16x8*)(UT2 + (16 * w + fr) * 136 + 32 * kk + 8 * fq);
#pragma unroll
            for (int mt = 0; mt < 8; ++mt) { const bf16x8 ac = *(const LAS bf16x8*)(TC + (16 * mt + fr) * 136 + 32 * kk + 8 * fq), as = *(const LAS bf16x8*)(TS + (16 * mt + fr) * 136 + 32 * kk + 8 * fq);
                re[mt] = mfma16(ac, b, re[mt]); im[mt] = mfma16(as, b, im[mt]); } }
        __syncthreads();
#pragma unroll
        for (int mt = 0; mt < 8; ++mt)
#pragma unroll
            for (int j = 0; j < 4; ++j) { const int p1 = 16 * mt + 4 * fq + j; const float tw0 = TWr[2 * p1], tw1 = TWr[2 * p1 + 1];
                const float tr = re[mt][j], ti = -im[mt][j]; const float orr = tr * tw0 + ti * tw1, oi = ti * tw0 - tr * tw1;
                OB[p1 * 264 + 16 * w + fr] = f2bf(orr); OB[p1 * 264 + 128 + 16 * w + fr] = f2bf(oi); }
        __syncthreads();
#pragma unroll
        for (int i = 0; i < 8; ++i) { const int ci = i * 512 + tid; const int p1 = ci >> 5, part = (ci >> 4) & 1, ch = ci & 15;
            const u32x4 v = *(const LAS u32x4*)(OB + p1 * 264 + part * 128 + 8 * ch);
            *(GAS u32x4*)((GAS bf16_t*)TP + ((size_t)p1 * 128 + s2) * 512 + part * 256 + half * 128 + 8 * ch) = v; }
        __syncthreads();
    }
}
__device__ __forceinline__ void fft_f3(const Ctx& c, int wid, int nw, const bf16_t* TP, const bf16_t* WC, const bf16_t* WSn, const bf16_t* C64, const bf16_t* S64, bf16_t* MIXED) {
    const int tid = c.tid, lane = c.lane, w = c.wave, fr = lane & 15, fq = lane >> 4;
    LAS bf16_t* TrT = (LAS bf16_t*)c.lds;
    LAS bf16_t* TiT = (LAS bf16_t*)(c.lds + 17408);
    LAS bf16_t* XB = (LAS bf16_t*)(c.lds + 34816 + w * 4352);
    LAS bf16_t* T64 = (LAS bf16_t*)(c.lds + 69632);
    { const int tbl = tid >> 8, r_ = (tid >> 2) & 63, ch = tid & 3; const GAS bf16_t* srcp = (const GAS bf16_t*)(tbl ? S64 : C64) + r_ * 64 + 16 * ch;
        *(LAS u32x4*)(T64 + tbl * 4608 + r_ * 72 + 16 * ch) = *(const GAS u32x4*)srcp; *(LAS u32x4*)(T64 + tbl * 4608 + r_ * 72 + 16 * ch + 8) = *(const GAS u32x4*)(srcp + 8); }
    bf16x8 fac[4], fas[4], fans[4];
#pragma unroll
    for (int kk = 0; kk < 4; ++kk) { fac[kk] = *(const GAS bf16x8*)((const GAS bf16_t*)WC + (16 * w + fr) * 128 + 32 * kk + 8 * fq); fas[kk] = *(const GAS bf16x8*)((const GAS bf16_t*)WSn + (16 * w + fr) * 128 + 32 * kk + 8 * fq);
#pragma unroll
        for (int e = 0; e < 8; ++e) fans[kk][e] = (short)(fas[kk][e] ^ (short)0x8000); }
    u32x4 pr0, pr1, pi0, pi1;
#define F3_LOAD(IT) do { const int p1_ = (IT) >> 2, g_ = (IT) & 3; const GAS bf16_t* src = (const GAS bf16_t*)TP + ((size_t)p1_ * 128 + (tid >> 2)) * 512 + g_ * 64 + 16 * (tid & 3); \
        pr0 = *(const GAS u32x4*)src; pr1 = *(const GAS u32x4*)(src + 8); pi0 = *(const GAS u32x4*)(src + 256); pi1 = *(const GAS u32x4*)(src + 264); } while (0)
    for (int it = wid; it < 512; it += nw) {
        const int p1 = it >> 2, g = it & 3;
        { const int s2 = tid >> 2, ch = tid & 3;
            F3_LOAD(it);
            const u32x4 r0 = pr0, r1 = pr1, i0 = pi0, i1 = pi1;
            LAS bf16_t* dn = TrT + s2 * 136 + 16 * ch;
            *(LAS u32x4*)dn = r0; *(LAS u32x4*)(dn + 8) = r1; *(LAS u32x4*)(dn + 64) = i0; *(LAS u32x4*)(dn + 72) = i1; }
        __syncthreads();
        f32x4 xr[4], xi[4];
#pragma unroll
        for (int nt = 0; nt < 4; ++nt) { xr[nt] = (f32x4){0.f, 0.f, 0.f, 0.f}; xi[nt] = (f32x4){0.f, 0.f, 0.f, 0.f}; }
        const unsigned vbt = (unsigned)(size_t)((LAS unsigned char*)TrT + (8 * fq + (fr >> 2)) * 272 + 8 * (fr & 3));
#define F3_RD(KK, NT, RL, RH, IL, IH) const s16x4 RL = tr_read<(KK) * 8704 + (NT) * 32>(vbt), RH = tr_read<(KK) * 8704 + 1088 + (NT) * 32>(vbt), IL = tr_read<(KK) * 8704 + 128 + (NT) * 32>(vbt), IH = tr_read<(KK) * 8704 + 1088 + 128 + (NT) * 32>(vbt)
#define F3_MM(KK, NT, RL, RH, IL, IH) do { const bf16x8 br = (bf16x8){RL[0], RL[1], RL[2], RL[3], RH[0], RH[1], RH[2], RH[3]}, bi = (bf16x8){IL[0], IL[1], IL[2], IL[3], IH[0], IH[1], IH[2], IH[3]}; \
            xr[NT] = mfma16(fac[KK], br, xr[NT]); xr[NT] = mfma16(fas[KK], bi, xr[NT]); xi[NT] = mfma16(fac[KK], bi, xi[NT]); xi[NT] = mfma16(fans[KK], br, xi[NT]); } while (0)
#define F3_HALF(KK, N0, N1) do { F3_RD(KK, N0, a0, a1, a2, a3); F3_RD(KK, N1, b0, b1, b2, b3); \
            asm volatile("s_waitcnt lgkmcnt(0)" ::: "memory"); __builtin_amdgcn_sched_barrier(0); \
            F3_MM(KK, N0, a0, a1, a2, a3); F3_MM(KK, N1, b0, b1, b2, b3); __builtin_amdgcn_sched_barrier(0); } while (0)
#define F3_KSTEP(KK) do { F3_HALF(KK, 0, 1); F3_HALF(KK, 2, 3); } while (0)
        F3_KSTEP(0); F3_KSTEP(1); F3_KSTEP(2); F3_KSTEP(3);
#undef F3_KSTEP
#undef F3_HALF
#undef F3_MM
#undef F3_RD
#pragma unroll
        for (int nt = 0; nt < 4; ++nt)
#pragma unroll
            for (int j = 0; j < 4; ++j) { XB[(4 * fq + j) * 136 + 16 * nt + fr] = f2bf(xr[nt][j]); XB[(4 * fq + j) * 136 + 64 + 16 * nt + fr] = f2bf(xi[nt][j]); }
        LDS_WAIT();
        f32x4 y[4];
#pragma unroll
        for (int nt = 0; nt < 4; ++nt) y[nt] = (f32x4){0.f, 0.f, 0.f, 0.f};
#pragma unroll
        for (int kk = 0; kk < 4; ++kk) { const bf16x8 a = *(const LAS bf16x8*)(XB + fr * 136 + 32 * kk + 8 * fq); const LAS bf16_t* tb = T64 + ((kk < 2) ? 0 : 4608);
#pragma unroll
            for (int nt = 0; nt < 4; ++nt) { const bf16x8 b = *(const LAS bf16x8*)(tb + (16 * nt + fr) * 72 + 32 * (kk & 1) + 8 * fq); y[nt] = mfma16(a, b, y[nt]); } }
#pragma unroll
        for (int j = 0; j < 4; ++j) { const size_t prow = (size_t)(p1 + 128 * (16 * w + 4 * fq + j));
#pragma unroll
            for (int nt = 0; nt < 4; ++nt) ((GAS bf16_t*)MIXED)[prow * 1024 + 256 + g * 64 + 16 * nt + fr] = f2bf(y[nt][j] * (1.f / 1024.f)); }
        __syncthreads();
    }
}

#define XB_TMO      128
#define XB_XCNT(j)  (256  + 64 * (j))
#define XB_XSUB(j)  (1280 + 64 * (j))
#define XB_XGEN(j)  (2304 + 64 * (j))
#define XB_TOP      3328
#define XB_TOPGEN   3392
#define XCD_BAR_WORDS 3456
#define XB_SPIN_CAP (1u << 18)

__device__ __forceinline__ unsigned xb_ld(unsigned* p)              { return __hip_atomic_load(p, __ATOMIC_RELAXED, __HIP_MEMORY_SCOPE_AGENT); }
__device__ __forceinline__ unsigned xb_add(unsigned* p, unsigned v) { return __hip_atomic_fetch_add(p, v, __ATOMIC_RELAXED, __HIP_MEMORY_SCOPE_AGENT); }
__device__ __forceinline__ unsigned xb_xcc_id() { return (unsigned)__builtin_amdgcn_s_getreg((3 << 11) | 20) & 0xFu; }
#define XB_SPIN(cond, bar) do { unsigned _sp = 0; while (cond) { __builtin_amdgcn_s_sleep(1); \
    if ((++_sp & 255u) == 0u) { if (xb_ld(&(bar)[XB_TMO])) break; if (_sp > XB_SPIN_CAP) { atomicAdd(&(bar)[XB_TMO], 1u); break; } } } } while (0)

struct XcdBarrier {
    unsigned* bar; unsigned x;
    volatile LAS unsigned* st;
};

__device__ __forceinline__ XcdBarrier xcd_barrier_post(unsigned* bar, volatile LAS unsigned* st) {
    XcdBarrier b; b.bar = bar; b.x = xb_xcc_id(); b.st = st;
    if (threadIdx.x == 0) (void)xb_add(&bar[XB_XCNT(b.x)], 1u);
    return b;
}
__device__ __forceinline__ void xcd_barrier_complete(unsigned* bar, unsigned x, unsigned& nloc, unsigned& nx) {
    const unsigned G = gridDim.x * gridDim.y * gridDim.z;
    unsigned sum, cnt, mine, sp = 0u;
    for (;;) {
        sum = 0u; cnt = 0u; mine = 0u;
#pragma unroll
        for (unsigned j = 0; j < 16; ++j) { const unsigned c = xb_ld(&bar[XB_XCNT(j)]); sum += c; cnt += (c > 0u) ? 1u : 0u; mine = (j == x) ? c : mine; }
        if (sum == G) break;
        __builtin_amdgcn_s_sleep(1);
        if ((++sp & 255u) == 0u) { if (xb_ld(&bar[XB_TMO])) break; if (sp > XB_SPIN_CAP) { atomicAdd(&bar[XB_TMO], 1u); break; } }
    }
    nloc = mine > 0u ? mine : 1u; nx = cnt > 0u ? cnt : 1u;
}

__device__ __forceinline__ void xcd_barrier(const XcdBarrier& b) {
    asm volatile("s_waitcnt vmcnt(0)" ::: "memory");
    __syncthreads();
    if (threadIdx.x == 0) {
        unsigned* bar = b.bar;
        __builtin_amdgcn_s_waitcnt(0);
        unsigned nloc = b.st[0], nx = b.st[1];
        if (nloc == 0u) { xcd_barrier_complete(bar, b.x, nloc, nx); b.st[0] = nloc; b.st[1] = nx; }
        const unsigned old = xb_add(&bar[XB_XSUB(b.x)], 1u);
        const unsigned gen = old / nloc;
        if (old + 1u == (gen + 1u) * nloc) {
            __builtin_amdgcn_fence(__ATOMIC_RELEASE, "agent");
            asm volatile("s_waitcnt vmcnt(0)" ::: "memory");
            const unsigned og = xb_add(&bar[XB_TOP], 1u);
            const unsigned tg = og / nx;
            if (og + 1u == (tg + 1u) * nx) xb_add(&bar[XB_TOPGEN], 1u);
            else XB_SPIN(xb_ld(&bar[XB_TOPGEN]) == tg, bar);
            __builtin_amdgcn_fence(__ATOMIC_ACQUIRE, "agent");
            xb_add(&bar[XB_XGEN(b.x)], 1u);
            asm volatile("s_waitcnt vmcnt(0)" ::: "memory");
        } else {
            XB_SPIN(xb_ld(&bar[XB_XGEN(b.x)]) == gen, bar);
            __builtin_amdgcn_fence(__ATOMIC_ACQUIRE, "agent");
            asm volatile("s_waitcnt vmcnt(0)" ::: "memory");
        }
    }
    __syncthreads();
}

typedef const __attribute__((address_space(4))) P* kargp;
__device__ __forceinline__ P ldP(kargp q) { P r; r.x = q->x; r.pos = q->pos; r.anw = q->anw; r.w_in = q->w_in; r.lbs = q->lbs; r.w_out = q->w_out; r.mnw = q->mnw; r.w_up = q->w_up; r.w_down = q->w_down; r.fnw = q->fnw;
    r.out = q->out; r.ws = q->ws; r.ph_lo = q->ph_lo; r.ph_hi = q->ph_hi; r.dup = q->dup; r.pad = q->pad; return r; }
constexpr int PH_PER_LAYER = 7, N_PHASES = DEPTH * PH_PER_LAYER + 2;
__global__ void __launch_bounds__(NTHR, 2) mega(P p_unused) {
    const kargp pk0 = (kargp)__builtin_amdgcn_kernarg_segment_ptr();
#define PL() ({ kargp q_ = pk0; asm volatile("" : "+s"(q_)); ldP(q_); })
    const int ph_lo = pk0->ph_lo, ph_hi = pk0->ph_hi, dupm = pk0->dup, padv = pk0->pad;
    unsigned char* const ws_base = pk0->ws;
    extern __shared__ __attribute__((aligned(16))) unsigned char lds_raw[];
    cg::grid_group grid = cg::this_grid();
#define WSL unsigned char* ws = ws_base; asm volatile("" : "+s"(ws))
    { volatile LAS unsigned* st0 = (volatile LAS unsigned*)((LAS unsigned char*)lds_raw + LDS_ST_OFF); if (threadIdx.x < 2) st0[threadIdx.x] = 0u; }
    __syncthreads();
    const XcdBarrier xbar = xcd_barrier_post((unsigned*)(ws_base + OFF_BAR), (volatile LAS unsigned*)((LAS unsigned char*)lds_raw + LDS_ST_OFF));
    for (int gp = ph_lo; gp < ph_hi; ++gp) {
        const int layer = (gp - 1) / PH_PER_LAYER, ph = (gp - 1) % PH_PER_LAYER;
        const int reps = (gp != 0 && gp != N_PHASES - 1 && ((dupm >> ph) & 1)) ? 2 : 1;
        for (int rep = 0; rep < reps; ++rep) {
        Ctx c; c.lds = (LAS unsigned char*)lds_raw; { int t_ = threadIdx.x; asm volatile("" : "+v"(t_)); c.tid = t_; } c.lane = c.tid & 63; c.wave = __builtin_amdgcn_readfirstlane(c.tid >> 6); c.bid = blockIdx.x; c.G = gridDim.x;
        if (gp == N_PHASES - 1) {
            { WSL; final_norm(c, (const bf16_t*)(ws + WS_XN), (const float*)(ws + OFF_SSQA), PL().fnw, PL().out); }
        } else if (gp == 0) {
            { const P pl = PL(); make_tables(c, pl); convert_weights(c, pl, 1, 0, 0, c.bid * 8 + c.wave, c.G * 8); }
            WSL;
            x_to_bf16_ssq(c, PL().x, (bf16_t*)(ws + WS_XN), (float*)(ws + OFF_SSQA));
        } else if (ph == 0) {
            WSL;
            pg8::Gemm g{(const bf16_t*)(ws + WS_XN), (const bf16_t*)(ws + W_IN), S, NIN, D}; pg8::StaticOrder so; so.init(S, NIN, c.G, c.bid);
            EpiIn E{(bf16_t*)(ws + WS_HQ), (bf16_t*)(ws + WS_HV), (bf16_t*)(ws + WS_HG), (bf16_t*)(ws + WS_FU), (bf16_t*)(ws + WS_AQ), (bf16_t*)(ws + WS_AK), (bf16_t*)(ws + WS_AV), (_Float16*)(ws + WS_LF),
                    (const float*)(ws + OFF_LB) + layer * 512, (const float*)(ws + OFF_CS), (const float*)(ws + OFF_SSQA), c.lds, 0};
            { pg8::Unit u0; u0.pm = 0; u0.pn = 0; so.next(0, u0); E.pm0 = u0.pm; fill_rs_table(c.lds, E.ssq, E.pm0, c.tid); }
            pg8::gemm_phase<EpiIn, pg8::StaticOrder, false>(c.lds, g, so, E, nullptr);
        } else if (ph == 1) {
            for (int r2 = 0; r2 < 1 + ((dupm >> 8) & 1); ++r2) { WSL; hgrn_passA(c, (const _Float16*)(ws + WS_LF), (const bf16_t*)(ws + WS_HV), PL().out  , (float*)(ws + WS_DEC)); }
            for (int r2 = 0; r2 < 1 + ((dupm >> 9) & 1); ++r2) { WSL; attn_phase(c, (const bf16_t*)(ws + WS_AQ), (const bf16_t*)(ws + WS_AK), (const bf16_t*)(ws + WS_AV), (bf16_t*)(ws + WS_OP), (float*)(ws + WS_LSE)); }
            for (int r2 = 0; r2 < 1 + ((dupm >> 10) & 1); ++r2) { WSL; fft_f1(c, (const bf16_t*)(ws + WS_FU), (const bf16_t*)(ws + OFF_W128C), (const bf16_t*)(ws + OFF_W128S), (const float*)(ws + OFF_TW), (bf16_t*)(ws + WS_TP)); }
        } else if (ph == 2) {
            WSL;
            const float* UT = (const float*)PL().out; const float* DEC = (const float*)(ws + WS_DEC); bf16_t* SS = (bf16_t*)(ws + WS_SS);
            const int nscan = (c.G >= 128) ? 64 : 0;
            if (c.bid < nscan) { for (int sb = c.bid; sb < 64; sb += nscan) hgrn_scan(sb, c.tid, UT, DEC, SS); }
            fft_f3(c, c.bid, c.G, (const bf16_t*)(ws + WS_TP), (const bf16_t*)(ws + OFF_W128C), (const bf16_t*)(ws + OFF_W128S), (const bf16_t*)(ws + OFF_C64), (const bf16_t*)(ws + OFF_S64), (bf16_t*)(ws + WS_MIXED));
            if (c.bid >= nscan) { if (nscan == 0) { for (int sb = c.bid; sb < 64; sb += c.G) hgrn_scan(sb, c.tid, UT, DEC, SS); }
                const int wid = c.bid - nscan, nw = c.G - nscan;
                attn_combine((const bf16_t*)(ws + WS_OP), (const float*)(ws + WS_LSE), (bf16_t*)(ws + WS_MIXED), 0, S * 64, wid, nw, c.tid);
                __syncthreads();
                { const P pl = PL(); convert_weights(c, pl, (layer + 1 < DEPTH) ? 3 : 2, layer + 1, layer, wid * 8 + c.wave, nw * 8); } }
        } else if (ph == 3) {
            WSL;
            hgrn_passC(c, (const _Float16*)(ws + WS_LF), (const bf16_t*)(ws + WS_HQ), (const bf16_t*)(ws + WS_HV), (const bf16_t*)(ws + WS_HG), (const bf16_t*)(ws + WS_SS), (bf16_t*)(ws + WS_MIXED));
        } else if (ph == 4) {
            WSL;
            pg8::Gemm g{(const bf16_t*)(ws + WS_MIXED), (const bf16_t*)(ws + W_OUT), S, D, D}; pg8::StaticOrder so; so.init(S, D, c.G, c.bid);
            EpiRes E{(bf16_t*)(ws + WS_XN), (float*)(ws + OFF_SSQM), D, nullptr, c.lds, 0};
            pg8::gemm_phase<EpiRes, pg8::StaticOrder, false>(c.lds, g, so, E, nullptr);
        } else if (ph == 5) {
            WSL;
            pg8::Gemm g{(const bf16_t*)(ws + WS_XN), (const bf16_t*)(ws + W_UP), S, FF, D}; pg8::StaticOrder so; so.init(S, FF, c.G, c.bid);
            EpiUp E{(bf16_t*)(ws + WS_H), FF};
            pg8::gemm_phase<EpiUp, pg8::StaticOrder, false>(c.lds, g, so, E, nullptr);
        } else {
            WSL;
            pg8::Gemm g{(const bf16_t*)(ws + WS_H), (const bf16_t*)(ws + W_DOWN), S, D, FF}; pg8::StaticOrder so; so.init(S, D, c.G, c.bid);
            EpiRes E{(bf16_t*)(ws + WS_XN), (float*)(ws + OFF_SSQA), D, (const float*)(ws + OFF_SSQM), c.lds, 0};
            { pg8::Unit u0; u0.pm = 0; u0.pn = 0; so.next(0, u0); E.pm0 = u0.pm; fill_rs_table(c.lds, E.ssq_in, E.pm0, c.tid); }
            pg8::gemm_phase<EpiRes, pg8::StaticOrder, false>(c.lds, g, so, E, nullptr);
        }
        if (reps > 1) __syncthreads();
        }
        if (gp + 1 < ph_hi) { if (padv == 0x7fffffff) grid.sync(); xcd_barrier(xbar); if (padv) { xcd_barrier(xbar); xcd_barrier(xbar); } }
    }
}
}

extern "C" void kernel_launch(void* const* d_in, const int* in_sizes, int n_in, void* d_out, int out_size, void* d_ws, size_t ws_size, hipStream_t stream) {
    static int grid = 0;
    if (grid == 0) {
        int dev = 0, cus = 0, per_cu = 0;
        hipGetDevice(&dev);
        hipDeviceGetAttribute(&cus, hipDeviceAttributeMultiprocessorCount, dev);
        if (hipFuncSetAttribute((const void*)mk::mega, hipFuncAttributeMaxDynamicSharedMemorySize, mk::LDS_BYTES) != hipSuccess) fprintf(stderr, "kernel_launch: hipFuncSetAttribute failed\n");
        if (hipOccupancyMaxActiveBlocksPerMultiprocessor(&per_cu, (const void*)mk::mega, mk::NTHR, mk::LDS_BYTES) != hipSuccess || per_cu < 1) { fprintf(stderr, "kernel_launch: occupancy query says %d\n", per_cu); per_cu = 1; }
        (void)hipGetLastError();
        grid = cus * per_cu; if (grid > 256) grid = 256; if (grid < 1) grid = 256;
    }
    mk::P p{};
    p.x = (const float*)d_in[0]; p.pos = (const int*)d_in[1]; p.anw = (const float*)d_in[2]; p.w_in = (const float*)d_in[3]; p.lbs = (const float*)d_in[4]; p.w_out = (const float*)d_in[5];
    p.mnw = (const float*)d_in[6]; p.w_up = (const float*)d_in[7]; p.w_down = (const float*)d_in[8]; p.fnw = (const float*)d_in[9]; p.out = (float*)d_out; p.ws = (unsigned char*)d_ws;
    p.ph_lo = 0; p.ph_hi = mk::N_PHASES;
#ifdef DUP_MASK
    p.dup = DUP_MASK;
#endif
#ifdef DUP_SYNC
    p.pad = 1;
#endif
    (void)hipMemsetAsync((unsigned char*)d_ws + mk::OFF_BAR, 0, mk::BAR_BYTES, stream);
    void* args[] = {&p};
    hipError_t e = hipLaunchCooperativeKernel((const void*)mk::mega, dim3(grid), dim3(mk::NTHR), args, mk::LDS_BYTES, stream);
    if (e != hipSuccess) fprintf(stderr, "kernel_launch: cooperative launch failed: %s (grid %d)\n", hipGetErrorString(e), grid);
}
```

```cpp
#include <hip/hip_runtime.h>
namespace pg8 {
#define PG8_LAS __attribute__((address_space(3)))
typedef unsigned short bf16_t;
typedef short bf16x8 __attribute__((ext_vector_type(8)));
typedef float f32x4 __attribute__((ext_vector_type(4)));
typedef unsigned u32x4 __attribute__((ext_vector_type(4)));
constexpr int BM = 256, BK = 64, HALF = 128, HTB = HALF * BK * 2  , STAGE_BYTES = 8 * HTB, NXCD = 8, WGM = 8;

__host__ __device__ __forceinline__ int lds_byte(int r, int c) { const int st = (r >> 4) * 2 + (c >> 5), rr = r & 15, cc = c & 31, ob = rr * 64 + cc * 2; return st * 1024 + (ob ^ (((ob >> 9) & 1) << 5)); }
__host__ __device__ __forceinline__ void stage_rc(int b, int& R, int& C) { const int st = b / 1024, sb = b % 1024, swz = sb ^ (((sb >> 9) & 1) << 5); R = (st >> 1) * 16 + swz / 64; C = (st & 1) * 32 + (swz % 64) / 2; }
__host__ __device__ __forceinline__ int perm32(int rho) { const int n = rho >> 4, i = rho & 15; return 8 * (i >> 2) + 4 * n + (i & 3); }

struct Unit { int pm, pn; };
struct Gemm { const bf16_t* A; const bf16_t* Bt; int M, N, K; };

struct StaticOrder {
    int nM, nN, nwg, G, c;
    __host__ __device__ void init(int M, int N, int G_, int c_) { nM = M / BM; nN = N / BM; nwg = nM * nN; G = G_; c = c_; }
    __host__ __device__ bool next(int i, Unit& u) const {
        const long L = (long)i * G + c; if (L >= nwg) return false;
        int wgid = (int)L; { const int q = nwg / NXCD, r = nwg % NXCD, xcd = wgid % NXCD, off = wgid / NXCD; wgid = (xcd < r ? xcd * (q + 1) : r * (q + 1) + (xcd - r) * q) + off; }
        const int nig = WGM * nN, gid = wgid / nig, fm = gid * WGM, gsz = (nM - fm) < WGM ? (nM - fm) : WGM;
        u.pm = fm + ((wgid % nig) % gsz); u.pn = (wgid % nig) / gsz; return true;
    }
    __device__ __forceinline__ void a_ready(const Unit&) const {}
    __device__ __forceinline__ void done(const Unit&) const {}
};
__device__ __forceinline__ unsigned cvt_pk_bf16(float lo, float hi) { unsigned r; asm volatile("v_cvt_pk_bf16_f32 %0, %1, %2" : "=v"(r) : "v"(lo), "v"(hi)); return r; }
typedef float f32x2 __attribute__((ext_vector_type(2)));
template <class Epi, class Sched, bool STAMP = false>
__device__ __forceinline__ void gemm_phase(PG8_LAS unsigned char* lds, const Gemm g, const Sched& S, const Epi& E, unsigned long long* stamps) {
    int tid_l = threadIdx.x; asm volatile("" : "+v"(tid_l)); const int tid = tid_l, wid = __builtin_amdgcn_readfirstlane(tid >> 6), lane = tid & 63, wr = wid >> 2, wc = wid & 3, fr = lane & 15, fq = lane >> 4;
    const int K = g.K, nt = K / BK;
    int ts_lo = 0, ts_hi = 0, nts = 0; const unsigned long long rt_entry = STAMP ? (unsigned long long)wall_clock64() : 0ull;
#define PG8_STAMP() do { if (STAMP && wid == 0 && nts < 64) { const unsigned long long _c = (unsigned long long)clock64(); \
        ts_lo = (lane == nts) ? (int)(unsigned)_c : ts_lo; ts_hi = (lane == nts) ? (int)(unsigned)(_c >> 32) : ts_hi; ++nts; } } while (0)
    PG8_STAMP();
    unsigned voffA[2], voffB[2];
#pragma unroll
    for (int i = 0; i < 2; ++i) { int R, C; stage_rc(tid * 16 + i * 8192, R, C); const int Rb = Epi::PERM ? ((R & ~31) + perm32(R & 31)) : R;
        voffA[i] = (unsigned)(R * K + C) * 2u; voffB[i] = (unsigned)(Rb * K + C) * 2u; }
    const size_t kstep = (size_t)(BK * 2);
    const size_t hstep = (size_t)HALF * K * 2;
    const size_t tstep = 2 * hstep;
    const unsigned ldsw = (unsigned)wid * 1024u;
    const int aoff = lds_byte(wr * 64 + fr, fq * 8), boff = lds_byte(wc * 32 + fr, fq * 8);
#define PG8_SA(b, h) (((b) * 2 + (h)) * HTB)
#define PG8_SB(b, h) ((4 + (b) * 2 + (h)) * HTB)
#define PG8_STAGE(bufoff, gbase, voff) do { _Pragma("unroll") for (int _i = 0; _i < 2; ++_i) \
        __builtin_amdgcn_global_load_lds((const unsigned*)((const char*)(gbase) + (voff)[_i]), (PG8_LAS unsigned*)(lds + (bufoff) + ldsw + _i * 8192), 16, 0, 0); } while (0)
#define PG8_LDA(dst, b, h) do { _Pragma("unroll") for (int m = 0; m < 4; ++m) _Pragma("unroll") for (int k = 0; k < 2; ++k) dst[m][k] = *(const PG8_LAS bf16x8*)(lds + PG8_SA(b, h) + aoff + m * 2048 + k * 1024); } while (0)
#define PG8_LDB(dst, b, h) do { _Pragma("unroll") for (int n = 0; n < 2; ++n) _Pragma("unroll") for (int k = 0; k < 2; ++k) dst[n][k] = *(const PG8_LAS bf16x8*)(lds + PG8_SB(b, h) + boff + n * 2048 + k * 1024); } while (0)
#define PG8_MMA(ai, bj, At, Bt) do { __builtin_amdgcn_s_setprio(1); _Pragma("unroll") for (int m = 0; m < 4; ++m) _Pragma("unroll") for (int n = 0; n < 2; ++n) _Pragma("unroll") for (int k = 0; k < 2; ++k) \
        acc[ai][bj][m][n] = __builtin_amdgcn_mfma_f32_16x16x32_bf16(Bt[n][k], At[m][k], acc[ai][bj][m][n], 0, 0, 0); __builtin_amdgcn_s_setprio(0); } while (0)
#define PG8_WAIT_V(n) asm volatile("s_waitcnt vmcnt(" #n ")" ::: "memory")
#define PG8_WAIT_L(n) asm volatile("s_waitcnt lgkmcnt(" #n ")" ::: "memory")
#define PG8_BAR __builtin_amdgcn_s_barrier()
#define PG8_SCHED __builtin_amdgcn_sched_barrier(0)
    Unit cur, nxt; int ui = 0;
    if (!S.next(0, cur)) return;
    f32x4 acc[2][2][4][2];
#pragma unroll
    for (int a = 0; a < 2; ++a)
#pragma unroll
        for (int b = 0; b < 2; ++b)
#pragma unroll
            for (int m = 0; m < 4; ++m)
#pragma unroll
                for (int n = 0; n < 2; ++n) acc[a][b][m][n] = (f32x4){0.f, 0.f, 0.f, 0.f};
    if constexpr (Epi::HAS_INIT) E.init(acc, cur, wr, wc, fr, fq);
    bf16x8 At[4][2], B0[2][2], B1[2][2];
    const char* cA = (const char*)g.A + (size_t)cur.pm * tstep; const char* cB = (const char*)g.Bt + (size_t)cur.pn * tstep;
    S.a_ready(cur);
    PG8_STAGE(PG8_SB(0, 0), cB, voffB); PG8_STAGE(PG8_SA(0, 0), cA, voffA); PG8_STAGE(PG8_SB(0, 1), cB + hstep, voffB); PG8_STAGE(PG8_SA(0, 1), cA + hstep, voffA);
    if (wr == 1) PG8_BAR;
    PG8_WAIT_V(4); PG8_BAR;
    PG8_STAGE(PG8_SB(1, 0), cB + kstep, voffB); PG8_STAGE(PG8_SA(1, 0), cA + kstep, voffA); PG8_STAGE(PG8_SB(1, 1), cB + hstep + kstep, voffB);
    PG8_WAIT_V(6); PG8_BAR;
    PG8_STAMP();
    for (;;) {
        const bool has_next = S.next(ui + 1, nxt);
        const char* nA = has_next ? (const char*)g.A + (size_t)nxt.pm * tstep : cA; const char* nB = has_next ? (const char*)g.Bt + (size_t)nxt.pn * tstep : cB;
        for (int t = 0; t < nt; t += 2) {
            const bool last = (t == nt - 2);
            const char* a1 = cA + (size_t)(t + 1) * kstep;
            const char* a2 = last ? nA : cA + (size_t)(t + 2) * kstep; const char* b2 = last ? nB : cB + (size_t)(t + 2) * kstep;
            const char* a3 = a2 + kstep; const char* b3 = b2 + kstep;
            if (last && has_next) S.a_ready(nxt);
            PG8_LDB(B0, 0, 0); PG8_SCHED; PG8_LDA(At, 0, 0); PG8_STAGE(PG8_SA(1, 1), a1 + hstep, voffA);
            PG8_WAIT_L(8); PG8_BAR; PG8_WAIT_L(0); PG8_MMA(0, 0, At, B0); PG8_BAR; PG8_SCHED;
            PG8_LDB(B1, 0, 1); PG8_STAGE(PG8_SB(0, 0), b2, voffB);
            PG8_BAR; PG8_WAIT_L(0); PG8_MMA(0, 1, At, B1); PG8_BAR;
            PG8_LDA(At, 0, 1); PG8_STAGE(PG8_SA(0, 0), a2, voffA);
            PG8_BAR; PG8_WAIT_L(0); PG8_MMA(1, 0, At, B0); PG8_BAR; PG8_SCHED;
            PG8_STAGE(PG8_SB(0, 1), b2 + hstep, voffB);
            PG8_WAIT_V(6); PG8_BAR; PG8_MMA(1, 1, At, B1); PG8_BAR;
            PG8_LDB(B0, 1, 0); PG8_SCHED; PG8_LDA(At, 1, 0); PG8_STAGE(PG8_SA(0, 1), a2 + hstep, voffA);
            PG8_WAIT_L(8); PG8_BAR; PG8_WAIT_L(0); PG8_MMA(0, 0, At, B0); PG8_BAR; PG8_SCHED;
            PG8_LDB(B1, 1, 1); PG8_STAGE(PG8_SB(1, 0), b3, voffB);
            PG8_BAR; PG8_WAIT_L(0); PG8_MMA(0, 1, At, B1); PG8_BAR;
            PG8_LDA(At, 1, 1); PG8_STAGE(PG8_SA(1, 0), a3, voffA);
            PG8_BAR; PG8_WAIT_L(0); PG8_MMA(1, 0, At, B0); PG8_BAR; PG8_SCHED;
            PG8_STAGE(PG8_SB(1, 1), b3 + hstep, voffB);
            PG8_WAIT_V(6); PG8_BAR; PG8_MMA(1, 1, At, B1); PG8_BAR;
        }
        PG8_STAMP();
        if constexpr (!Epi::AFTER_DRAIN) { E(acc, cur, wr, wc, fr, fq); S.done(cur); }
        PG8_STAMP();
        if (!has_next) break;
#pragma unroll
        for (int a = 0; a < 2; ++a)
#pragma unroll
            for (int b = 0; b < 2; ++b)
#pragma unroll
                for (int m = 0; m < 4; ++m)
#pragma unroll
                    for (int n = 0; n < 2; ++n) acc[a][b][m][n] = (f32x4){0.f, 0.f, 0.f, 0.f};
        if constexpr (Epi::HAS_INIT) E.init(acc, nxt, wr, wc, fr, fq);
        cur = nxt; cA = nA; cB = nB; ++ui;
    }
    PG8_WAIT_V(0);
    if (wr == 0) PG8_BAR;
    PG8_BAR;
    if constexpr (Epi::AFTER_DRAIN) { E.fused(acc, cur, wr, wc, fr, fq, lds, wid, lane); S.done(cur); }
    PG8_STAMP();
    if (STAMP && wid == 0) { stamps[lane] = lane < nts ? (((unsigned long long)(unsigned)ts_hi << 32) | (unsigned)ts_lo) : 0ull;
        if (lane == 62) stamps[62] = rt_entry; if (lane == 63) stamps[63] = (unsigned long long)wall_clock64(); }
#undef PG8_STAMP
#undef PG8_SA
#undef PG8_SB
#undef PG8_STAGE
#undef PG8_LDA
#undef PG8_LDB
#undef PG8_MMA
#undef PG8_WAIT_V
#undef PG8_WAIT_L
#undef PG8_BAR
#undef PG8_SCHED
}
}

#include <hip/hip_cooperative_groups.h>
#include <cstdio>
namespace cg = cooperative_groups;
namespace mk {
using pg8::bf16_t; using pg8::bf16x8; using pg8::f32x4; using pg8::u32x4; using pg8::cvt_pk_bf16; using pg8::Unit;
#define LAS __attribute__((address_space(3)))
#define GAS __attribute__((address_space(1)))
typedef unsigned u32x2 __attribute__((ext_vector_type(2)));
typedef float f32x2 __attribute__((ext_vector_type(2)));
typedef _Float16 f16x8 __attribute__((ext_vector_type(8)));

constexpr int S = 16384, D = 1024, NIN = 3072, FF = 4096, DEPTH = 4;
constexpr int NTHR = 512;
constexpr int LDS_BYTES = 151552;
constexpr size_t MiB = (size_t)1 << 20;
constexpr size_t OFF_LB = 0, OFF_W128C = 16384, OFF_W128S = 49152, OFF_C64 = 81920, OFF_S64 = 90112, OFF_TW = 131072, OFF_CS = 1 * MiB;
constexpr size_t OFF_BAR = 524288, BAR_BYTES = 16384, OFF_SSQA = 5 * 1048576, OFF_SSQM = 6 * 1048576;
constexpr int LDS_ST_OFF = 151040;
constexpr size_t WS_W = 8 * MiB, W_IN = WS_W, W_OUT = WS_W + 6 * MiB, W_UP = WS_W + 8 * MiB, W_DOWN = WS_W + 16 * MiB;
constexpr size_t WS_XN = 32 * MiB, WS_UT = 32 * MiB;
constexpr size_t WS_HQ = 64 * MiB, WS_HV = 72 * MiB, WS_HG = 80 * MiB, WS_FU = 88 * MiB, WS_LF = 96 * MiB;
constexpr size_t WS_AQ = 128 * MiB, WS_AK = 144 * MiB, WS_MIXED = 128 * MiB, WS_AV = 160 * MiB, WS_SS = 160 * MiB;
constexpr size_t WS_OP = 176 * MiB, WS_TP = 224 * MiB, WS_DEC = 240 * MiB, WS_LSE = 241 * MiB;
constexpr size_t WS_H = 64 * MiB;

struct P { const float* x; const int* pos; const float* anw; const float* w_in; const float* lbs; const float* w_out; const float* mnw;
           const float* w_up; const float* w_down; const float* fnw; float* out; unsigned char* ws; int ph_lo, ph_hi, dup, pad; };
struct Ctx { LAS unsigned char* lds; int tid, lane, wave, bid, G; };

__device__ __forceinline__ float bf2f(unsigned short b) { return __uint_as_float(((unsigned)b) << 16); }
__device__ __forceinline__ unsigned short f2bf(float f) { return (unsigned short)(cvt_pk_bf16(f, 0.f) & 0xffffu); }
__device__ __forceinline__ f32x4 mfma16(bf16x8 a, bf16x8 b, f32x4 c) { return __builtin_amdgcn_mfma_f32_16x16x32_bf16(a, b, c, 0, 0, 0); }
__device__ __forceinline__ float wave_sum(float v) {
#pragma unroll
    for (int o = 1; o < 64; o <<= 1) v += __shfl_xor(v, o);
    return v;
}
__device__ __forceinline__ float silu(float v) { return v * __builtin_amdgcn_rcpf(1.f + __expf(-v)); }
#define LDS_WAIT() asm volatile("s_waitcnt lgkmcnt(0)" ::: "memory")

constexpr int LDS_RS_OFF = 131072;
__device__ __forceinline__ float row_rs(const float* ssq, int row) { const f32x4* q = (const f32x4*)(ssq + (size_t)row * 16); const f32x4 a = q[0], b = q[1], c = q[2], d = q[3];
    const float s = (((a[0] + a[1]) + (a[2] + a[3])) + ((b[0] + b[1]) + (b[2] + b[3]))) + (((c[0] + c[1]) + (c[2] + c[3])) + ((d[0] + d[1]) + (d[2] + d[3]))); return 1.f / sqrtf(s * (1.f / D) + 1e-6f); }
__device__ __forceinline__ float rs_of(LAS unsigned char* lds, const float* ssq, int pm0, int pm, int row) { return *(const LAS float*)(lds + LDS_RS_OFF + 4 * (row & 255)); }
__device__ __forceinline__ void fill_rs_table(LAS unsigned char* lds, const float* ssq, int pm0, int tid) { if (tid < 256) *(LAS float*)(lds + LDS_RS_OFF + 4 * tid) = row_rs(ssq, pm0 * 256 + tid); __syncthreads(); }
struct EpiRes {
    static constexpr bool PERM = true, AFTER_DRAIN = false, HAS_INIT = true;
    bf16_t* xnb; float* ssq; int ldc; const float* ssq_in; LAS unsigned char* lds; int pm0;
    __device__ __forceinline__ void init(f32x4 (&acc)[2][2][4][2], const Unit& u, int wr, int wc, int fr, int fq) const {
        const int row0 = u.pm * 256 + wr * 64 + fr, col0 = u.pn * 256 + wc * 32 + 8 * fq; const GAS bf16_t* xg = (const GAS bf16_t*)xnb;
#pragma unroll
        for (int ai = 0; ai < 2; ++ai)
#pragma unroll
            for (int m = 0; m < 4; ++m) { const int row = row0 + ai * 128 + m * 16; const size_t off = (size_t)row * ldc + col0;
                float isc = 1.f; if (ssq_in) { const float r = rs_of(lds, ssq_in, pm0, u.pm, row); isc = 1.f / (r * r); }
#pragma unroll
                for (int bj = 0; bj < 2; ++bj) { const u32x4 w = *(const GAS u32x4*)(xg + off + bj * 128);
                    acc[ai][bj][m][0] = (f32x4){__uint_as_float(w.x << 16), __uint_as_float(w.x & 0xffff0000u), __uint_as_float(w.y << 16), __uint_as_float(w.y & 0xffff0000u)} * isc;
                    acc[ai][bj][m][1] = (f32x4){__uint_as_float(w.z << 16), __uint_as_float(w.z & 0xffff0000u), __uint_as_float(w.w << 16), __uint_as_float(w.w & 0xffff0000u)} * isc; } }
    }
    __device__ __forceinline__ void operator()(const f32x4 (&acc)[2][2][4][2], const Unit& u, int wr, int wc, int fr_, int fq_) const {
        int fr = fr_, fq = fq_; asm volatile("" : "+v"(fr), "+v"(fq));
        const int row0 = u.pm * 256 + wr * 64 + fr, col0 = u.pn * 256 + wc * 32 + 8 * fq; GAS bf16_t* xg = (GAS bf16_t*)xnb; GAS float* sg = (GAS float*)ssq;
#pragma unroll
        for (int ai = 0; ai < 2; ++ai)
#pragma unroll
            for (int m = 0; m < 4; ++m) { const int row = row0 + ai * 128 + m * 16; const size_t off = (size_t)row * ldc + col0; float s = 0.f;
                float sc = 1.f; if (ssq_in) { const float r = rs_of(lds, ssq_in, pm0, u.pm, row); sc = r * r; }
#pragma unroll
                for (int bj = 0; bj < 2; ++bj) { const f32x4 v0 = acc[ai][bj][m][0] * sc, v1 = acc[ai][bj][m][1] * sc;
                    s += ((v0[0] * v0[0] + v0[1] * v0[1]) + (v0[2] * v0[2] + v0[3] * v0[3])) + ((v1[0] * v1[0] + v1[1] * v1[1]) + (v1[2] * v1[2] + v1[3] * v1[3]));
                    u32x4 w; w.x = cvt_pk_bf16(v0[0], v0[1]); w.y = cvt_pk_bf16(v0[2], v0[3]); w.z = cvt_pk_bf16(v1[0], v1[1]); w.w = cvt_pk_bf16(v1[2], v1[3]);
                    *(GAS u32x4*)(xg + off + bj * 128) = w; }
                s += __shfl_xor(s, 16); s += __shfl_xor(s, 32);
                if (fq == 0) sg[(size_t)row * 16 + u.pn * 4 + wc] = s; }
    }
};
struct EpiUp {
    static constexpr bool PERM = true, AFTER_DRAIN = false, HAS_INIT = false;
    bf16_t* O; int ldc;
    __device__ __forceinline__ void operator()(const f32x4 (&acc)[2][2][4][2], const Unit& u, int wr, int wc, int fr_, int fq_) const {
        int fr = fr_, fq = fq_; asm volatile("" : "+v"(fr), "+v"(fq));
        const int row0 = u.pm * 256 + wr * 64 + fr, col0 = u.pn * 256 + wc * 32 + 8 * fq;
#pragma unroll
        for (int ai = 0; ai < 2; ++ai)
#pragma unroll
            for (int m = 0; m < 4; ++m) { const int row = row0 + ai * 128 + m * 16; bf16_t* rowp = O + (size_t)row * ldc + col0;
#pragma unroll
                for (int bj = 0; bj < 2; ++bj) { f32x4 v0 = acc[ai][bj][m][0], v1 = acc[ai][bj][m][1];
#pragma unroll
                    for (int e = 0; e < 4; ++e) { float a = fmaxf(v0[e], 0.f), b = fmaxf(v1[e], 0.f); v0[e] = a * a; v1[e] = b * b; }
                    u32x4 w; w.x = cvt_pk_bf16(v0[0], v0[1]); w.y = cvt_pk_bf16(v0[2], v0[3]); w.z = cvt_pk_bf16(v1[0], v1[1]); w.w = cvt_pk_bf16(v1[2], v1[3]);
                    *(GAS u32x4*)((GAS bf16_t*)rowp + bj * 128) = w; } }
    }
};
struct EpiIn {
    static constexpr bool PERM = true, AFTER_DRAIN = false, HAS_INIT = false;
    bf16_t *HQ, *HV, *HG, *FU, *AQ, *AK, *AV; _Float16* LF; const float* LB; const float* CS; const float* ssq; LAS unsigned char* lds; int pm0;
    __device__ __forceinline__ void operator()(const f32x4 (&acc)[2][2][4][2], const Unit& u, int wr, int wc, int fr_, int fq_) const {
        int fr = fr_, fq = fq_; asm volatile("" : "+v"(fr), "+v"(fq));
        const int pn = u.pn; const int row0 = u.pm * 256 + wr * 64 + fr; const int c8 = wc * 32 + 8 * fq;
        if (pn >= 6 && pn <= 9) {
            const bool isq = pn < 8; bf16_t* dst = isq ? AQ : AK; const int headg = (pn - (isq ? 6 : 8)) * 4 + wc; const float sc0 = isq ? 0.125f * 1.4426950408889634f : 1.f; const int i0 = 8 * fq;
#pragma unroll
            for (int ai = 0; ai < 2; ++ai)
#pragma unroll
                for (int m = 0; m < 4; ++m) { const int row = row0 + ai * 128 + m * 16; const float sc = sc0 * rs_of(lds, ssq, pm0, u.pm, row);
                    const GAS f32x4* cs = (const GAS f32x4*)((const GAS float*)CS + ((size_t)row * 32 + i0) * 2);
                    float o1[8], o2[8];
#pragma unroll
                    for (int n = 0; n < 2; ++n)
#pragma unroll
                        for (int e2 = 0; e2 < 2; ++e2) { const f32x4 t = cs[n * 2 + e2];
                            { const int e = 2 * e2; const float x1 = acc[ai][0][m][n][e], x2 = acc[ai][1][m][n][e]; o1[4 * n + e] = (x1 * t[0] - x2 * t[1]) * sc; o2[4 * n + e] = (x2 * t[0] + x1 * t[1]) * sc; }
                            { const int e = 2 * e2 + 1; const float x1 = acc[ai][0][m][n][e], x2 = acc[ai][1][m][n][e]; o1[4 * n + e] = (x1 * t[2] - x2 * t[3]) * sc; o2[4 * n + e] = (x2 * t[2] + x1 * t[3]) * sc; } }
                    u32x4 w1, w2; w1.x = cvt_pk_bf16(o1[0], o1[1]); w1.y = cvt_pk_bf16(o1[2], o1[3]); w1.z = cvt_pk_bf16(o1[4], o1[5]); w1.w = cvt_pk_bf16(o1[6], o1[7]);
                    w2.x = cvt_pk_bf16(o2[0], o2[1]); w2.y = cvt_pk_bf16(o2[2], o2[3]); w2.z = cvt_pk_bf16(o2[4], o2[5]); w2.w = cvt_pk_bf16(o2[6], o2[7]);
                    bf16_t* rp = dst + (size_t)row * 512 + headg * 64 + i0;
                    *(GAS u32x4*)(GAS bf16_t*)rp = w1; *(GAS u32x4*)((GAS bf16_t*)rp + 32) = w2; if (m == 3) asm volatile("" ::: "memory"); }
        } else if (pn == 2 || pn == 3) {
            const int dir = pn - 2;
#pragma unroll
            for (int bj = 0; bj < 2; ++bj) { const int col = bj * 128 + c8; const f32x4 l0 = *(const f32x4*)(LB + dir * 256 + col), l1 = *(const f32x4*)(LB + dir * 256 + col + 4);
#pragma unroll
                for (int ai = 0; ai < 2; ++ai)
#pragma unroll
                    for (int m = 0; m < 4; ++m) { const int row = row0 + ai * 128 + m * 16; f32x4 r0, r1; const float rs = rs_of(lds, ssq, pm0, u.pm, row);
#pragma unroll
                        for (int e = 0; e < 4; ++e) { const float s0 = __builtin_amdgcn_rcpf(1.f + __expf(-acc[ai][bj][m][0][e] * rs)), s1 = __builtin_amdgcn_rcpf(1.f + __expf(-acc[ai][bj][m][1][e] * rs));
                            r0[e] = __builtin_amdgcn_logf(l0[e] + (1.f - l0[e]) * s0); r1[e] = __builtin_amdgcn_logf(l1[e] + (1.f - l1[e]) * s1); }
                        f16x8 hv; hv[0] = (_Float16)r0[0]; hv[1] = (_Float16)r0[1]; hv[2] = (_Float16)r0[2]; hv[3] = (_Float16)r0[3]; hv[4] = (_Float16)r1[0]; hv[5] = (_Float16)r1[1]; hv[6] = (_Float16)r1[2]; hv[7] = (_Float16)r1[3];
                        *(GAS f16x8*)((GAS _Float16*)LF + ((size_t)dir * S + row) * 256 + col) = hv; asm volatile("" ::: "memory"); } }
        } else {
            bf16_t* dst; int ld, cb; bool act = false;
            if (pn == 0) { dst = HQ; ld = 256; cb = 0; act = true; } else if (pn == 1) { dst = HV; ld = 256; cb = 0; } else if (pn == 4) { dst = HG; ld = 256; cb = 0; act = true; }
            else if (pn == 5) { dst = FU; ld = 256; cb = 0; } else { dst = AV; ld = 512; cb = (pn - 10) * 256; }
#pragma unroll
            for (int ai = 0; ai < 2; ++ai)
#pragma unroll
                for (int m = 0; m < 4; ++m) { const int row = row0 + ai * 128 + m * 16; bf16_t* rowp = dst + (size_t)row * ld + cb + c8; const float rs = rs_of(lds, ssq, pm0, u.pm, row);
#pragma unroll
                    for (int bj = 0; bj < 2; ++bj) { f32x4 v0 = acc[ai][bj][m][0] * rs, v1 = acc[ai][bj][m][1] * rs;
                        if (act) {
#pragma unroll
                            for (int e = 0; e < 4; ++e) { v0[e] = silu(v0[e]); v1[e] = silu(v1[e]); } }
                        u32x4 w; w.x = cvt_pk_bf16(v0[0], v0[1]); w.y = cvt_pk_bf16(v0[2], v0[3]); w.z = cvt_pk_bf16(v1[0], v1[1]); w.w = cvt_pk_bf16(v1[2], v1[3]);
                        *(GAS u32x4*)((GAS bf16_t*)rowp + bj * 128) = w; } }
        }
    }
};

__device__ __forceinline__ void make_tables(const Ctx& c, const P& p) {
    unsigned char* ws = p.ws;
    const int gt = c.bid * NTHR + c.tid, gs = c.G * NTHR;
    float* LB = (float*)(ws + OFF_LB);
    for (int e = gt; e < 512; e += gs) {
        float v[DEPTH], mx = -1e30f; for (int l = 0; l < DEPTH; ++l) { v[l] = p.lbs[l * 512 + e]; mx = fmaxf(mx, v[l]); }
        float sum = 0.f; for (int l = 0; l < DEPTH; ++l) { v[l] = expf(v[l] - mx); sum += v[l]; }
        float cum = 0.f; LB[e] = 0.f; for (int l = 1; l < DEPTH; ++l) { cum += v[l] / sum; LB[l * 512 + e] = cum; }
    }
    bf16_t* WC = (bf16_t*)(ws + OFF_W128C); bf16_t* WS_ = (bf16_t*)(ws + OFF_W128S);
    for (int e = gt; e < 16384; e += gs) { const int a = e >> 7, b = e & 127, idx = (a * b) & 127; const float x = (float)idx * (1.f / 64.f); WC[e] = f2bf(cospif(x)); WS_[e] = f2bf(sinpif(x)); }
    bf16_t* C64 = (bf16_t*)(ws + OFF_C64); bf16_t* S64 = (bf16_t*)(ws + OFF_S64);
    for (int e = gt; e < 4096; e += gs) { const int a = e >> 6, b = e & 63, idx = (a * b) & 63; const float x = (float)idx * (1.f / 32.f); C64[e] = f2bf(cospif(x)); S64[e] = f2bf(sinpif(x)); }
    float* TW = (float*)(ws + OFF_TW);
    for (int e = gt; e < 16384; e += gs) { const int a = e >> 7, b = e & 127, idx = a * b; const float x = (float)idx * (1.f / 8192.f); TW[2 * e] = cospif(x); TW[2 * e + 1] = sinpif(x); }
    float* CS = (float*)(ws + OFF_CS);
    for (int e = gt; e < S * 32; e += gs) { const int s = e >> 5, i = e & 31; const float invf = powf(10000.f, -(float)(2 * i) / 64.f); const float ang = (float)p.pos[s] * invf;
        double xr = (double)ang * 0.31830988618379067154; xr = xr - 2.0 * rint(xr * 0.5); const float xf = (float)xr; CS[2 * e] = cospif(xf); CS[2 * e + 1] = sinpif(xf); }
}
struct CvItem { const float* W; int K, N; bf16_t* WT; int k0, n0, drow0; const float* nw; };
__device__ __forceinline__ CvItem cv_decode(const P& p, int r, int n_in, int lin, int lrest) {
    constexpr int I_OUT = 16 * 32, I_UP = 16 * 128;
    CvItem it;
    if (r < n_in) { const int kb = r / 96, nb = r % 96; const int pn = nb >> 3; int drow = nb * 32;
        if (pn >= 6 && pn <= 9) { const int sb = nb & 7, head = sb >> 1, half = sb & 1; drow = pn * 256 + (4 * half + head) * 32; }
        it.W = p.w_in + (size_t)lin * D * NIN; it.K = D; it.N = NIN; it.WT = (bf16_t*)(p.ws + W_IN); it.k0 = kb * 64; it.n0 = nb * 32; it.drow0 = drow; it.nw = p.anw + lin * D; return it; }
    r -= n_in;
    if (r < I_OUT) { const int kb = r / 32, nb = r % 32; it.W = p.w_out + (size_t)lrest * D * D; it.K = D; it.N = D; it.WT = (bf16_t*)(p.ws + W_OUT); it.k0 = kb * 64; it.n0 = nb * 32; it.drow0 = nb * 32; it.nw = nullptr; return it; }
    r -= I_OUT;
    if (r < I_UP) { const int kb = r / 128, nb = r % 128; it.W = p.w_up + (size_t)lrest * D * FF; it.K = D; it.N = FF; it.WT = (bf16_t*)(p.ws + W_UP); it.k0 = kb * 64; it.n0 = nb * 32; it.drow0 = nb * 32; it.nw = p.mnw + lrest * D; return it; }
    r -= I_UP;
    { const int kb = r / 32, nb = r % 32; it.W = p.w_down + (size_t)lrest * FF * D; it.K = FF; it.N = D; it.WT = (bf16_t*)(p.ws + W_DOWN); it.k0 = kb * 64; it.n0 = nb * 32; it.drow0 = nb * 32; it.nw = nullptr; return it; }
}
__device__ __forceinline__ void cv_load(const CvItem& it, f32x4 (&v)[8], int lane) {
    const int cq = lane & 7, r8 = lane >> 3;
#pragma unroll
    for (int i = 0; i < 8; ++i) { const int kk = 8 * i + r8; v[i] = *(const GAS f32x4*)((const GAS float*)it.W + (size_t)(it.k0 + kk) * it.N + it.n0 + 4 * cq); if (it.nw) v[i] = v[i] * ((const GAS float*)it.nw)[it.k0 + kk]; }
}
__device__ __forceinline__ void cv_store(const CvItem& it, const f32x4 (&v)[8], LAS float* scr, int lane) {
    const int cq = lane & 7, r8 = lane >> 3;
#pragma unroll
    for (int i = 0; i < 8; ++i) { const int kk = 8 * i + r8; LAS float* d = scr + kk * 33 + 4 * cq; d[0] = v[i][0]; d[1] = v[i][1]; d[2] = v[i][2]; d[3] = v[i][3]; }
    LDS_WAIT();
    const int cc = lane & 7;
#pragma unroll
    for (int j = 0; j < 4; ++j) { const int n = (lane >> 3) + 8 * j; const LAS float* s = scr + (8 * cc) * 33 + n;
        u32x4 o; o.x = cvt_pk_bf16(s[0 * 33], s[1 * 33]); o.y = cvt_pk_bf16(s[2 * 33], s[3 * 33]); o.z = cvt_pk_bf16(s[4 * 33], s[5 * 33]); o.w = cvt_pk_bf16(s[6 * 33], s[7 * 33]);
        *(GAS u32x4*)((GAS bf16_t*)it.WT + (size_t)(it.drow0 + n) * it.K + it.k0 + 8 * cc) = o; }
    LDS_WAIT();
}
__device__ __forceinline__ void convert_weights(const Ctx& c, const P& p, int which, int lin, int lrest, int gw, int NGW) {
    LAS float* scr = (LAS float*)(c.lds + c.wave * 16384);
    constexpr int I_IN = 16 * 96, I_OUT = 16 * 32, I_UP = 16 * 128, I_DN = 64 * 32;
    const int n_in = (which & 1) ? I_IN : 0, n_rest = (which & 2) ? (I_OUT + I_UP + I_DN) : 0, ntot = n_in + n_rest;
    int r = gw; if (r >= ntot) return;
    CvItem cur = cv_decode(p, r, n_in, lin, lrest); f32x4 v[8]; cv_load(cur, v, c.lane);
    for (;;) {
        const int rn = r + NGW; const bool more = rn < ntot;
        CvItem nxt = cur; f32x4 vn[8];
        if (more) { nxt = cv_decode(p, rn, n_in, lin, lrest); cv_load(nxt, vn, c.lane); }
        cv_store(cur, v, scr, c.lane);
        if (!more) break;
#pragma unroll
        for (int i = 0; i < 8; ++i) v[i] = vn[i];
        cur = nxt; r = rn;
    }
}
__device__ __forceinline__ void x_to_bf16_ssq(const Ctx& c, const float* src, bf16_t* xnb, float* ssq) {
    const int gw = c.bid * 8 + c.wave, NGW = c.G * 8, lane = c.lane; const GAS float* sg = (const GAS float*)src;
    if (gw >= S) return;
    f32x4 v[4];
#pragma unroll
    for (int j = 0; j < 4; ++j) v[j] = ((const GAS f32x4*)(sg + (size_t)gw * D) + lane)[64 * j];
    for (int m = gw; m < S; m += NGW) {
        const int mn = (m + NGW < S) ? m + NGW : m; f32x4 vn[4];
#pragma unroll
        for (int j = 0; j < 4; ++j) vn[j] = ((const GAS f32x4*)(sg + (size_t)mn * D) + lane)[64 * j];
        float s = 0.f;
#pragma unroll
        for (int j = 0; j < 4; ++j) s += (v[j][0] * v[j][0] + v[j][1] * v[j][1]) + (v[j][2] * v[j][2] + v[j][3] * v[j][3]);
        s = wave_sum(s);
        GAS u32x2* o = (GAS u32x2*)((GAS bf16_t*)xnb + (size_t)m * D) + lane;
#pragma unroll
        for (int j = 0; j < 4; ++j) { u32x2 q; q.x = cvt_pk_bf16(v[j][0], v[j][1]); q.y = cvt_pk_bf16(v[j][2], v[j][3]); o[64 * j] = q; }
        if (lane < 16) ((GAS float*)ssq)[(size_t)m * 16 + lane] = (lane == 0) ? s : 0.f;
#pragma unroll
        for (int j = 0; j < 4; ++j) v[j] = vn[j];
    }
}
__device__ __forceinline__ void norm_rows(const Ctx& c, const float* src, const float* w, bf16_t* dst_bf, float* dst_f) {
    const int gw = c.bid * 8 + c.wave, NGW = c.G * 8, lane = c.lane;
    f32x4 w4[4];
#pragma unroll
    for (int j = 0; j < 4; ++j) w4[j] = ((const f32x4*)w)[lane + 64 * j];
    for (int m = gw; m < S; m += NGW) {
        const f32x4* xr = (const f32x4*)(src + (size_t)m * D) + lane; f32x4 v[4]; float s = 0.f;
#pragma unroll
        for (int j = 0; j < 4; ++j) { v[j] = xr[64 * j]; s += (v[j][0] * v[j][0] + v[j][1] * v[j][1]) + (v[j][2] * v[j][2] + v[j][3] * v[j][3]); }
        const float rs = 1.f / sqrtf(wave_sum(s) * (1.f / D) + 1e-6f);
        if (dst_bf) { u32x2* o = (u32x2*)(dst_bf + (size_t)m * D) + lane;
#pragma unroll
            for (int j = 0; j < 4; ++j) { u32x2 q; q.x = cvt_pk_bf16(v[j][0] * rs * w4[j][0], v[j][1] * rs * w4[j][1]); q.y = cvt_pk_bf16(v[j][2] * rs * w4[j][2], v[j][3] * rs * w4[j][3]); o[64 * j] = q; } }
        else { f32x4* o = (f32x4*)(dst_f + (size_t)m * D) + lane;
#pragma unroll
            for (int j = 0; j < 4; ++j) o[64 * j] = v[j] * rs * w4[j]; }
    }
}

__device__ __forceinline__ void final_norm(const Ctx& c, const bf16_t* xnb, const float* ssq, const float* w, float* out) {
    const int gw = c.bid * 8 + c.wave, NGW = c.G * 8, lane = c.lane;
    if (gw >= S) return;
    f32x4 w4[4];
#pragma unroll
    for (int j = 0; j < 4; ++j) w4[j] = ((const GAS f32x4*)(const GAS float*)w)[4 * lane + j];
    const GAS bf16_t* xg = (const GAS bf16_t*)xnb; const GAS float* sg = (const GAS float*)ssq;
    u32x4 a = ((const GAS u32x4*)(xg + (size_t)gw * D) + 2 * lane)[0], b = ((const GAS u32x4*)(xg + (size_t)gw * D) + 2 * lane)[1];
    f32x4 q0 = ((const GAS f32x4*)(sg + (size_t)gw * 16))[0], q1 = ((const GAS f32x4*)(sg + (size_t)gw * 16))[1], q2 = ((const GAS f32x4*)(sg + (size_t)gw * 16))[2], q3 = ((const GAS f32x4*)(sg + (size_t)gw * 16))[3];
    for (int m = gw; m < S; m += NGW) {
        const int mn = (m + NGW < S) ? m + NGW : m;
        const u32x4 an = ((const GAS u32x4*)(xg + (size_t)mn * D) + 2 * lane)[0], bn = ((const GAS u32x4*)(xg + (size_t)mn * D) + 2 * lane)[1];
        const f32x4 n0 = ((const GAS f32x4*)(sg + (size_t)mn * 16))[0], n1 = ((const GAS f32x4*)(sg + (size_t)mn * 16))[1], n2 = ((const GAS f32x4*)(sg + (size_t)mn * 16))[2], n3 = ((const GAS f32x4*)(sg + (size_t)mn * 16))[3];
        const float ssum = (((q0[0] + q0[1]) + (q0[2] + q0[3])) + ((q1[0] + q1[1]) + (q1[2] + q1[3]))) + (((q2[0] + q2[1]) + (q2[2] + q2[3])) + ((q3[0] + q3[1]) + (q3[2] + q3[3])));
        const float rs = 1.f / sqrtf(ssum * (1.f / D) + 1e-6f);
        GAS f32x4* o = (GAS f32x4*)((GAS float*)out + (size_t)m * D) + 4 * lane;
        o[0] = (f32x4){__uint_as_float(a.x << 16), __uint_as_float(a.x & 0xffff0000u), __uint_as_float(a.y << 16), __uint_as_float(a.y & 0xffff0000u)} * rs * w4[0];
        o[1] = (f32x4){__uint_as_float(a.z << 16), __uint_as_float(a.z & 0xffff0000u), __uint_as_float(a.w << 16), __uint_as_float(a.w & 0xffff0000u)} * rs * w4[1];
        o[2] = (f32x4){__uint_as_float(b.x << 16), __uint_as_float(b.x & 0xffff0000u), __uint_as_float(b.y << 16), __uint_as_float(b.y & 0xffff0000u)} * rs * w4[2];
        o[3] = (f32x4){__uint_as_float(b.z << 16), __uint_as_float(b.z & 0xffff0000u), __uint_as_float(b.w << 16), __uint_as_float(b.w & 0xffff0000u)} * rs * w4[3];
        a = an; b = bn; q0 = n0; q1 = n1; q2 = n2; q3 = n3;
    }
}
typedef short s16x4 __attribute__((ext_vector_type(4)));
constexpr int VS_PITCH = 144;
template <int OFF> __device__ __forceinline__ s16x4 tr_read(unsigned vb) { s16x4 r; asm volatile("ds_read_b64_tr_b16 %0, %1 offset:%2" : "=&v"(r) : "v"(vb), "i"(OFF) : "memory"); return r; }
__device__ __forceinline__ void hgrn_passA(const Ctx& c, const _Float16* LF, const bf16_t* HV, float* UT, float* DEC) {
    const int h = c.wave >> 1, dir = c.wave & 1, lane = c.lane, fr = lane & 15, fq = lane >> 4;
    LAS bf16_t* KlT = (LAS bf16_t*)(c.lds + c.wave * 9216);
    LAS bf16_t* VT = (LAS bf16_t*)(c.lds + 8 * 9216 + h * 9216);
    for (int n = c.bid; n < 256; n += c.G) {
        const GAS _Float16* lfp = (const GAS _Float16*)LF + ((size_t)dir * S + n * 64) * 256 + h * 64 + lane;
        float lf[64];
#pragma unroll
        for (int t = 0; t < 64; ++t) lf[t] = (float)lfp[(size_t)t * 256];
        float run = 1.f;
        if (dir == 0) {
#pragma unroll
            for (int s = 63; s >= 0; --s) { const float f = __builtin_amdgcn_exp2f(lf[s]); lf[s] = (1.f - f) * run; run *= f; }
        } else {
#pragma unroll
            for (int s = 0; s < 64; ++s) { const float f = __builtin_amdgcn_exp2f(lf[s]); lf[s] = (1.f - f) * run; run *= f; }
        }
#pragma unroll
        for (int i = 0; i < 8; ++i) { u32x4 w; w.x = cvt_pk_bf16(lf[8 * i], lf[8 * i + 1]); w.y = cvt_pk_bf16(lf[8 * i + 2], lf[8 * i + 3]); w.z = cvt_pk_bf16(lf[8 * i + 4], lf[8 * i + 5]); w.w = cvt_pk_bf16(lf[8 * i + 6], lf[8 * i + 7]);
            *(LAS u32x4*)(KlT + lane * 72 + 8 * i) = w; }
        ((GAS float*)DEC)[((size_t)(n * 2 + dir) * 4 + h) * 64 + lane] = run;
        { const GAS bf16_t* vp = (const GAS bf16_t*)HV + (size_t)(n * 64 + 32 * dir) * 256 + h * 64; u32x4 vw[4];
#pragma unroll
            for (int i = 0; i < 4; ++i) { const int ci = i * 64 + lane; vw[i] = *(const GAS u32x4*)(vp + (size_t)(ci >> 3) * 256 + 8 * (ci & 7)); }
#pragma unroll
            for (int i = 0; i < 4; ++i) { const int ci = i * 64 + lane; *(LAS u32x4*)(VT + (32 * dir + (ci >> 3)) * 72 + 8 * (ci & 7)) = vw[i]; } }
        __syncthreads();
        f32x4 acc[4][4];
#pragma unroll
        for (int a = 0; a < 4; ++a)
#pragma unroll
            for (int b = 0; b < 4; ++b) acc[a][b] = (f32x4){0.f, 0.f, 0.f, 0.f};
        { const unsigned vbp = (unsigned)(size_t)((LAS unsigned char*)VT + (8 * fq + (fr >> 2)) * 144 + 8 * (fr & 3));
#define PA_KSTEP(KK) do { const s16x4 l0 = tr_read<(KK) * 4608>(vbp), h0 = tr_read<(KK) * 4608 + 576>(vbp), l1 = tr_read<(KK) * 4608 + 32>(vbp), h1 = tr_read<(KK) * 4608 + 576 + 32>(vbp); \
            const s16x4 l2 = tr_read<(KK) * 4608 + 64>(vbp), h2 = tr_read<(KK) * 4608 + 576 + 64>(vbp), l3 = tr_read<(KK) * 4608 + 96>(vbp), h3 = tr_read<(KK) * 4608 + 576 + 96>(vbp); \
            bf16x8 b[4]; _Pragma("unroll") for (int t = 0; t < 4; ++t) b[t] = *(const LAS bf16x8*)(KlT + (16 * t + fr) * 72 + 32 * (KK) + 8 * fq); \
            asm volatile("s_waitcnt lgkmcnt(0)" ::: "memory"); __builtin_amdgcn_sched_barrier(0); \
            bf16x8 a[4]; a[0] = (bf16x8){l0[0], l0[1], l0[2], l0[3], h0[0], h0[1], h0[2], h0[3]}; a[1] = (bf16x8){l1[0], l1[1], l1[2], l1[3], h1[0], h1[1], h1[2], h1[3]}; \
            a[2] = (bf16x8){l2[0], l2[1], l2[2], l2[3], h2[0], h2[1], h2[2], h2[3]}; a[3] = (bf16x8){l3[0], l3[1], l3[2], l3[3], h3[0], h3[1], h3[2], h3[3]}; \
            _Pragma("unroll") for (int mt = 0; mt < 4; ++mt) _Pragma("unroll") for (int nt = 0; nt < 4; ++nt) acc[mt][nt] = mfma16(b[nt], a[mt], acc[mt][nt]); __builtin_amdgcn_sched_barrier(0); } while (0)
            PA_KSTEP(0); PA_KSTEP(1);
#undef PA_KSTEP
        }
        int lo_ = fr * 64 + 4 * fq; asm volatile("" : "+v"(lo_));
        GAS float* up = (GAS float*)UT + ((size_t)(n * 2 + dir) * 4 + h) * 4096 + lo_;
#pragma unroll
        for (int mt = 0; mt < 4; ++mt)
#pragma unroll
            for (int nt = 0; nt < 4; ++nt) *(GAS f32x4*)(up + (16 * mt) * 64 + 16 * nt) = acc[mt][nt];
        __syncthreads();
    }
}
__device__ __forceinline__ void hgrn_scan(int sb, int tid, const float* UT, const float* DEC, bf16_t* SS) {
    const int dir = sb >> 5, hk0 = (sb & 31) * 512, h = hk0 >> 12, k = tid & 63;
    const GAS float* ub = (const GAS float*)UT + (size_t)dir * 16384 + hk0; const GAS float* db = (const GAS float*)DEC + (size_t)(dir * 4 + h) * 64; GAS bf16_t* sbp = (GAS bf16_t*)SS + (size_t)dir * 16384 + hk0;
    float st = 0.f;
    for (int n0 = 0; n0 < 256; n0 += 64) {
        float u[64], d[64];
#pragma unroll
        for (int i = 0; i < 64; ++i) { const int n = dir ? (255 - n0 - i) : (n0 + i); u[i] = (ub + (size_t)n * 32768)[tid]; d[i] = (db + (size_t)n * 512)[k]; }
#pragma unroll
        for (int i = 0; i < 64; ++i) { const int n = dir ? (255 - n0 - i) : (n0 + i); (sbp + (size_t)n * 32768)[tid] = f2bf(st); st = d[i] * st + u[i]; }
    }
}
__device__ __forceinline__ void hgrn_passC(const Ctx& c, const _Float16* LF, const bf16_t* HQ, const bf16_t* HV, const bf16_t* HG, const bf16_t* SS, bf16_t* MIXED) {
    const int h = c.wave >> 1, dir = c.wave & 1, lane = c.lane, fr = lane & 15, fq = lane >> 4;
    LAS bf16_t* bA = (LAS bf16_t*)(c.lds + c.wave * 18432);
    LAS bf16_t* bB = bA + 64 * 72;
    for (int n = c.bid; n < 256; n += c.G) {
        const GAS _Float16* lfp = (const GAS _Float16*)LF + ((size_t)dir * S + n * 64) * 256 + h * 64 + lane;
        const GAS bf16_t* qp = (const GAS bf16_t*)HQ + (size_t)(n * 64) * 256 + h * 64 + lane;
        float b[64]; unsigned qi[32];
#pragma unroll
        for (int t = 0; t < 64; ++t) b[t] = (float)lfp[(size_t)t * 256];
        u32x4 sreg[8];
        { const GAS bf16_t* sp = (const GAS bf16_t*)SS + ((size_t)(n * 2 + dir) * 4 + h) * 4096;
#pragma unroll
            for (int i = 0; i < 8; ++i) sreg[i] = *(const GAS u32x4*)(sp + (i * 64 + lane) * 8); }
        if (dir == 0) {
#pragma unroll
            for (int t = 1; t < 64; ++t) b[t] += b[t - 1];
        } else {
#pragma unroll
            for (int t = 62; t >= 0; --t) b[t] += b[t + 1];
        }
        const float ref = dir == 0 ? b[31] : b[32];
#pragma unroll
        for (int t2 = 0; t2 < 32; ++t2) { float qiv[2];
#pragma unroll
            for (int o = 0; o < 2; ++o) { const int t = 2 * t2 + o;
                float prev; if (dir == 0) prev = (t == 0) ? 0.f : b[t - 1]; else prev = (t == 63) ? 0.f : b[t + 1];
                const float lf = b[t] - prev; const float kv = 1.f - __builtin_amdgcn_exp2f(lf); const float q = bf2f(qp[(size_t)t * 256]);
                const float qe = q * __builtin_amdgcn_exp2f(fminf(b[t] - ref, 115.f)), ke = kv * __builtin_amdgcn_exp2f(fminf(ref - b[t], 115.f)); qiv[o] = q * __builtin_amdgcn_exp2f(b[t]);
                bA[t * 72 + lane] = f2bf(qe); bB[t * 72 + lane] = f2bf(ke); }
            qi[t2] = cvt_pk_bf16(qiv[0], qiv[1]); }
        LDS_WAIT();
        f32x4 sc[4][4];
#pragma unroll
        for (int a = 0; a < 4; ++a)
#pragma unroll
            for (int bb = 0; bb < 4; ++bb) sc[a][bb] = (f32x4){0.f, 0.f, 0.f, 0.f};
#pragma unroll
        for (int kk = 0; kk < 2; ++kk) { bf16x8 a[4], bq[4];
#pragma unroll
            for (int t = 0; t < 4; ++t) { a[t] = *(const LAS bf16x8*)(bA + (16 * t + fr) * 72 + 32 * kk + 8 * fq); bq[t] = *(const LAS bf16x8*)(bB + (16 * t + fr) * 72 + 32 * kk + 8 * fq); }
#pragma unroll
            for (int mt = 0; mt < 4; ++mt)
#pragma unroll
                for (int nt = 0; nt < 4; ++nt) sc[nt][mt] = mfma16(bq[nt], a[mt], sc[nt][mt]); }
        LDS_WAIT();
        bf16x8 pb[4][2];
#pragma unroll
        for (int mt = 0; mt < 4; ++mt)
#pragma unroll
            for (int kk = 0; kk < 2; ++kk) { float pv[8];
#pragma unroll
                for (int hh = 0; hh < 2; ++hh)
#pragma unroll
                    for (int j = 0; j < 4; ++j) { const int nt = 2 * kk + hh; const int s = 16 * nt + 4 * fq + j, t = 16 * mt + fr; const bool ok = dir == 0 ? (s <= t) : (s >= t); pv[4 * hh + j] = ok ? sc[nt][mt][j] : 0.f; }
                u32x4 pw; pw.x = cvt_pk_bf16(pv[0], pv[1]); pw.y = cvt_pk_bf16(pv[2], pv[3]); pw.z = cvt_pk_bf16(pv[4], pv[5]); pw.w = cvt_pk_bf16(pv[6], pv[7]);
                __builtin_memcpy(&pb[mt][kk], &pw, 16); }
        { const GAS bf16_t* vp = (const GAS bf16_t*)HV + (size_t)(n * 64) * 256 + h * 64; u32x4 vw[8];
#pragma unroll
            for (int i = 0; i < 8; ++i) { const int ci = i * 64 + lane; vw[i] = *(const GAS u32x4*)(vp + (size_t)(ci >> 3) * 256 + 8 * (ci & 7)); }
#pragma unroll
            for (int i = 0; i < 8; ++i) { const int ci = i * 64 + lane; *(LAS u32x4*)(bB + (ci >> 3) * 72 + 8 * (ci & 7)) = vw[i]; } }
        LDS_WAIT();
        f32x4 o[4][4];
#pragma unroll
        for (int a = 0; a < 4; ++a)
#pragma unroll
            for (int bb = 0; bb < 4; ++bb) o[a][bb] = (f32x4){0.f, 0.f, 0.f, 0.f};
        { const unsigned vbv = (unsigned)(size_t)((LAS unsigned char*)bB + (4 * fq + (fr >> 2)) * 144 + 8 * (fr & 3));
#define PC_KSTEP(KK) do { const s16x4 l0 = tr_read<(KK) * 4608>(vbv), h0 = tr_read<(KK) * 4608 + 2304>(vbv), l1 = tr_read<(KK) * 4608 + 32>(vbv), h1 = tr_read<(KK) * 4608 + 2304 + 32>(vbv); \
            const s16x4 l2 = tr_read<(KK) * 4608 + 64>(vbv), h2 = tr_read<(KK) * 4608 + 2304 + 64>(vbv), l3 = tr_read<(KK) * 4608 + 96>(vbv), h3 = tr_read<(KK) * 4608 + 2304 + 96>(vbv); \
            asm volatile("s_waitcnt lgkmcnt(0)" ::: "memory"); __builtin_amdgcn_sched_barrier(0); \
            bf16x8 bq[4]; bq[0] = (bf16x8){l0[0], l0[1], l0[2], l0[3], h0[0], h0[1], h0[2], h0[3]}; bq[1] = (bf16x8){l1[0], l1[1], l1[2], l1[3], h1[0], h1[1], h1[2], h1[3]}; \
            bq[2] = (bf16x8){l2[0], l2[1], l2[2], l2[3], h2[0], h2[1], h2[2], h2[3]}; bq[3] = (bf16x8){l3[0], l3[1], l3[2], l3[3], h3[0], h3[1], h3[2], h3[3]}; \
            _Pragma("unroll") for (int mt = 0; mt < 4; ++mt) _Pragma("unroll") for (int nt = 0; nt < 4; ++nt) o[mt][nt] = mfma16(bq[nt], pb[mt][KK], o[mt][nt]); } while (0)
            PC_KSTEP(0); PC_KSTEP(1);
#undef PC_KSTEP
        }
        LDS_WAIT();
#pragma unroll
        for (int t2 = 0; t2 < 32; ++t2) { bA[(2 * t2) * 72 + lane] = (bf16_t)(qi[t2] & 0xffffu); bA[(2 * t2 + 1) * 72 + lane] = (bf16_t)(qi[t2] >> 16); }
#pragma unroll
        for (int i = 0; i < 8; ++i) { const int ci = i * 64 + lane; *(LAS u32x4*)(bB + (ci >> 3) * 72 + 8 * (ci & 7)) = sreg[i]; }
        LDS_WAIT();
#pragma unroll
        for (int kk = 0; kk < 2; ++kk) { bf16x8 a[4], bq[4];
#pragma unroll
            for (int t = 0; t < 4; ++t) { a[t] = *(const LAS bf16x8*)(bA + (16 * t + fr) * 72 + 32 * kk + 8 * fq); bq[t] = *(const LAS bf16x8*)(bB + (16 * t + fr) * 72 + 32 * kk + 8 * fq); }
#pragma unroll
            for (int mt = 0; mt < 4; ++mt)
#pragma unroll
                for (int nt = 0; nt < 4; ++nt) o[mt][nt] = mfma16(bq[nt], a[mt], o[mt][nt]); }
        LDS_WAIT();
        LAS float* ox = (LAS float*)bA;
        if (dir == 1) {
#pragma unroll
            for (int mt = 0; mt < 4; ++mt)
#pragma unroll
                for (int nt = 0; nt < 4; ++nt) *(LAS f32x4*)(ox + (16 * mt + fr) * 72 + 16 * nt + 4 * fq) = o[mt][nt];
        }
        __syncthreads();
        if (dir == 0) {
            const LAS float* px = (const LAS float*)(c.lds + (c.wave + 1) * 18432);
#pragma unroll
            for (int mt = 0; mt < 4; ++mt) { const int t = 16 * mt + fr; float ss = 0.f;
#pragma unroll
                for (int nt = 0; nt < 4; ++nt) { const f32x4 v = o[mt][nt] + *(const LAS f32x4*)(px + t * 72 + 16 * nt + 4 * fq); o[mt][nt] = v; ss += (v[0] * v[0] + v[1] * v[1]) + (v[2] * v[2] + v[3] * v[3]); }
                ss += __shfl_xor(ss, 16); ss += __shfl_xor(ss, 32);
                const float rs = __builtin_amdgcn_rsqf(ss * (1.f / 64.f) + 1e-6f);
                const size_t ro = (size_t)(n * 64 + t);
#pragma unroll
                for (int nt = 0; nt < 4; ++nt) { const int col = h * 64 + 16 * nt + 4 * fq; const u32x2 g2 = *(const GAS u32x2*)((const GAS bf16_t*)HG + ro * 256 + col);
                    const float g0 = __uint_as_float(g2.x << 16), g1 = __uint_as_float(g2.x & 0xffff0000u), g2f = __uint_as_float(g2.y << 16), g3 = __uint_as_float(g2.y & 0xffff0000u);
                    u32x2 wv; wv.x = cvt_pk_bf16(o[mt][nt][0] * rs * g0, o[mt][nt][1] * rs * g1); wv.y = cvt_pk_bf16(o[mt][nt][2] * rs * g2f, o[mt][nt][3] * rs * g3);
                    *(GAS u32x2*)((GAS bf16_t*)MIXED + ro * 1024 + col) = wv; } }
        }
        __syncthreads();
    }
}

template <int I> __device__ __forceinline__ void pv_step(f32x4 (&o)[4], unsigned vb, bf16x8 pa) {
    constexpr int B = I * 32 * VS_PITCH, H = 16 * VS_PITCH;
    const s16x4 l0 = tr_read<B>(vb), l1 = tr_read<B + 32>(vb), l2 = tr_read<B + 64>(vb), l3 = tr_read<B + 96>(vb);
    s16x4 h0 = (s16x4){0, 0, 0, 0}, h1 = h0, h2 = h0, h3 = h0;
    if constexpr (I < 4) { h0 = tr_read<B + H>(vb); h1 = tr_read<B + H + 32>(vb); h2 = tr_read<B + H + 64>(vb); h3 = tr_read<B + H + 96>(vb); }
    asm volatile("s_waitcnt lgkmcnt(0)" ::: "memory"); __builtin_amdgcn_sched_barrier(0);
#define PKV(L, Hh) (bf16x8){L[0], L[1], L[2], L[3], Hh[0], Hh[1], Hh[2], Hh[3]}
    o[0] = mfma16(PKV(l0, h0), pa, o[0]); o[1] = mfma16(PKV(l1, h1), pa, o[1]); o[2] = mfma16(PKV(l2, h2), pa, o[2]); o[3] = mfma16(PKV(l3, h3), pa, o[3]);
#undef PKV
}
__device__ __forceinline__ void attn_phase(const Ctx& c, const bf16_t* AQ, const bf16_t* AK, const bf16_t* AV, bf16_t* OP, float* LSE) {
    const int tid = c.tid, lane = c.lane, w = c.wave, fr = lane & 15, fq = lane >> 4;
    const GAS bf16_t* AQg = (const GAS bf16_t*)AQ; const GAS bf16_t* AKg = (const GAS bf16_t*)AK; const GAS bf16_t* AVg = (const GAS bf16_t*)AV; GAS bf16_t* OPg = (GAS bf16_t*)OP; GAS float* LSEg = (GAS float*)LSE;
    u32x4 kreg[4], vreg[4]; bf16x8 qreg[2];
#define ATT_LOAD(IT) do { const int p_ = (IT) >> 10, rem_ = (IT) & 1023, h_ = rem_ >> 7, gi_ = rem_ & 127; const int dsh_ = 2 * p_, Lp_ = S >> dsh_, ngs_ = 7 - dsh_; \
        const int r_ = gi_ >> ngs_, Jb_ = (gi_ & ((1 << ngs_) - 1)) * 128; \
        _Pragma("unroll") for (int ps = 0; ps < 4; ++ps) { const int kl = ps * 64 + (tid >> 3), ch = tid & 7; const int J = Jb_ - 64 + kl; const bool ok = (J >= 0) && (J < Lp_); \
            kreg[ps] = (u32x4){0u, 0u, 0u, 0u}; vreg[ps] = (u32x4){0u, 0u, 0u, 0u}; \
            if (ok) { const size_t off = ((size_t)((J << dsh_) + r_)) * 512 + h_ * 64 + 8 * ch; kreg[ps] = *(const GAS u32x4*)(AKg + off); vreg[ps] = *(const GAS u32x4*)(AVg + off); } } \
        { const size_t qo = ((size_t)(((Jb_ + 16 * w + fr) << dsh_) + r_)) * 512 + h_ * 64 + 8 * fq; qreg[0] = *(const GAS bf16x8*)(AQg + qo); qreg[1] = *(const GAS bf16x8*)(AQg + qo + 32); } } while (0)
    const bool xmap = (c.G == 256); const int nk = xmap ? 12 : (3072 - c.bid + c.G - 1) / c.G;
#define ATT_ITEM(K) (xmap ? (((K) >> 2) * 1024 + (c.bid & 7) * 128 + ((K) & 3) * 32 + (c.bid >> 3)) : (c.bid + (K) * c.G))
    if (nk > 0) { const int it0 = ATT_ITEM(0); ATT_LOAD(it0); }
    for (int kq = 0; kq < nk; ++kq) {
        const int it = ATT_ITEM(kq);
        LAS bf16_t* Ks = (LAS bf16_t*)(c.lds + (kq & 1) * 73728);
        LAS bf16_t* Vt = (LAS bf16_t*)(c.lds + (kq & 1) * 73728 + 36864);
        const int p = it >> 10, rem = it & 1023, h = rem >> 7, gi = rem & 127;
        const int dsh = 2 * p, Lp = S >> dsh, ngs = 7 - dsh;
        const int r = gi >> ngs, Jb = (gi & ((1 << ngs) - 1)) * 128;
#pragma unroll
        for (int ps = 0; ps < 4; ++ps) { const int kl = ps * 64 + (tid >> 3), ch = tid & 7; const u32x4 vv = vreg[ps];
            *(LAS u32x4*)(Ks + kl * 72 + 8 * ch) = kreg[ps];
            *(LAS u32x4*)((LAS unsigned char*)Vt + kl * VS_PITCH + 16 * ch) = vv; }
        bf16x8 qf[2]; qf[0] = qreg[0]; qf[1] = qreg[1];
        __syncthreads();
        if (kq + 1 < nk) { const int nit = ATT_ITEM(kq + 1); ATT_LOAD(nit); }
        const int J0 = Jb + 16 * w, kb = 16 * w;
        f32x4 st[9];
#pragma unroll
        for (int tt = 0; tt < 9; ++tt) { st[tt] = (f32x4){0.f, 0.f, 0.f, 0.f};
#pragma unroll
            for (int kk = 0; kk < 2; ++kk) { const bf16x8 a = *(const LAS bf16x8*)(Ks + (kb + 16 * tt + fr) * 72 + 32 * kk + 8 * fq); st[tt] = mfma16(a, qf[kk], st[tt]); } }
#pragma unroll
        for (int j = 0; j < 4; ++j) { if (4 * fq + j < fr) st[0][j] = -1e30f; if (4 * fq + j > fr) st[8][j] = -1e30f; }
        if (Jb == 0 || Jb + 128 == Lp) {
#pragma unroll
            for (int tt = 0; tt < 9; ++tt)
#pragma unroll
                for (int j = 0; j < 4; ++j) { const int Jk = J0 - 64 + 16 * tt + 4 * fq + j; if ((unsigned)Jk >= (unsigned)Lp) st[tt][j] = -1e30f; } }
        float mx = -1e30f;
#pragma unroll
        for (int tt = 0; tt < 9; ++tt) mx = fmaxf(mx, fmaxf(fmaxf(st[tt][0], st[tt][1]), fmaxf(st[tt][2], st[tt][3])));
        mx = fmaxf(mx, __shfl_xor(mx, 16)); mx = fmaxf(mx, __shfl_xor(mx, 32));
        float ls = 0.f;
#pragma unroll
        for (int tt = 0; tt < 9; ++tt)
#pragma unroll
            for (int j = 0; j < 4; ++j) { const float pv = __builtin_amdgcn_exp2f(st[tt][j] - mx); st[tt][j] = pv; ls += pv; }
        ls += __shfl_xor(ls, 16); ls += __shfl_xor(ls, 32);
        f32x4 o[4];
#pragma unroll
        for (int nt = 0; nt < 4; ++nt) o[nt] = (f32x4){0.f, 0.f, 0.f, 0.f};
        bf16x8 pa[5];
#pragma unroll
        for (int i = 0; i < 5; ++i) { u32x4 pw; pw.x = cvt_pk_bf16(st[2 * i][0], st[2 * i][1]); pw.y = cvt_pk_bf16(st[2 * i][2], st[2 * i][3]);
            if (i < 4) { pw.z = cvt_pk_bf16(st[2 * i + 1][0], st[2 * i + 1][1]); pw.w = cvt_pk_bf16(st[2 * i + 1][2], st[2 * i + 1][3]); } else { pw.z = 0u; pw.w = 0u; }
            __builtin_memcpy(&pa[i], &pw, 16); }
        { const unsigned vb = (unsigned)(size_t)((LAS unsigned char*)Vt + (kb + 4 * fq + (fr >> 2)) * VS_PITCH + 8 * (fr & 3));
            pv_step<0>(o, vb, pa[0]); pv_step<1>(o, vb, pa[1]); pv_step<2>(o, vb, pa[2]); pv_step<3>(o, vb, pa[3]); pv_step<4>(o, vb, pa[4]); }
        const float linv = __builtin_amdgcn_rcpf(ls); const size_t qpos = (size_t)(((J0 + fr) << dsh) + r);
#pragma unroll
        for (int nt = 0; nt < 4; ++nt) { u32x2 wv; wv.x = cvt_pk_bf16(o[nt][0] * linv, o[nt][1] * linv); wv.y = cvt_pk_bf16(o[nt][2] * linv, o[nt][3] * linv);
            *(GAS u32x2*)(OPg + ((size_t)p * S + qpos) * 512 + h * 64 + 16 * nt + 4 * fq) = wv; }
        if (fq == 0) LSEg[((size_t)p * S + qpos) * 8 + h] = mx + __builtin_amdgcn_logf(ls);
    }
    __syncthreads();
#undef ATT_LOAD
#undef ATT_ITEM
}
constexpr int CMB_SPLIT = 7168 * 64;
__device__ __forceinline__ void attn_combine(const bf16_t* OP, const float* LSE, bf16_t* MIXED, int e0, int e1, int wid, int nw, int tid) {
    const GAS float* LSg = (const GAS float*)LSE; const GAS bf16_t* OPg = (const GAS bf16_t*)OP; GAS bf16_t* MXg = (GAS bf16_t*)MIXED;
    const int stride = nw * NTHR;
    for (int eb = e0 + wid * NTHR + tid; eb < e1; eb += 4 * stride) {
        float l[4][3]; u32x4 av[4][3]; bool ok[4];
#pragma unroll
        for (int q = 0; q < 4; ++q) { const int e = eb + q * stride; ok[q] = e < e1; const int ee = ok[q] ? e : eb; const int s = ee >> 6, h = (ee >> 3) & 7, ch = ee & 7; const size_t off = (size_t)s * 512 + h * 64 + 8 * ch;
#pragma unroll
            for (int pp = 0; pp < 3; ++pp) { l[q][pp] = LSg[((size_t)pp * S + s) * 8 + h]; av[q][pp] = *(const GAS u32x4*)(OPg + (size_t)pp * S * 512 + off); } }
#pragma unroll
        for (int q = 0; q < 4; ++q) { const int e = eb + q * stride; const int s = e >> 6, h = (e >> 3) & 7, ch = e & 7;
            float l0 = l[q][0], l1 = l[q][1], l2 = l[q][2];
            const float m = fmaxf(l0, fmaxf(l1, l2)); l0 = __builtin_amdgcn_exp2f(l0 - m); l1 = __builtin_amdgcn_exp2f(l1 - m); l2 = __builtin_amdgcn_exp2f(l2 - m); const float inv = __builtin_amdgcn_rcpf(l0 + l1 + l2); l0 *= inv; l1 *= inv; l2 *= inv;
            const u32x4 a = av[q][0], b2 = av[q][1], cc = av[q][2]; u32x4 o;
#pragma unroll
            for (int i = 0; i < 4; ++i) { const float lo = l0 * __uint_as_float(a[i] << 16) + l1 * __uint_as_float(b2[i] << 16) + l2 * __uint_as_float(cc[i] << 16);
                const float hi = l0 * __uint_as_float(a[i] & 0xffff0000u) + l1 * __uint_as_float(b2[i] & 0xffff0000u) + l2 * __uint_as_float(cc[i] & 0xffff0000u); o[i] = cvt_pk_bf16(lo, hi); }
            if (ok[q]) *(GAS u32x4*)(MXg + (size_t)s * 1024 + 512 + h * 64 + 8 * ch) = o; }
    }
}

__device__ __forceinline__ void fft_f1(const Ctx& c, const bf16_t* FU, const bf16_t* WC, const bf16_t* WSn, const float* TW, bf16_t* TP) {
    const int tid = c.tid, lane = c.lane, w = c.wave, fr = lane & 15, fq = lane >> 4;
    LAS bf16_t* UT2 = (LAS bf16_t*)c.lds;
    LAS bf16_t* OB = (LAS bf16_t*)(c.lds + 34816);
    LAS bf16_t* TC = (LAS bf16_t*)(c.lds + 102400);
    LAS float* TWr = (LAS float*)(c.lds + 137216);
    LAS bf16_t* TS = OB;
    const GAS bf16_t* WCg = (const GAS bf16_t*)WC; const GAS bf16_t* WSg = (const GAS bf16_t*)WSn; const GAS bf16_t* FUg = (const GAS bf16_t*)FU;
    for (int it = c.bid; it < 256; it += c.G) {
        const int s2 = it >> 1, half = it & 1;
#pragma unroll
        for (int i = 0; i < 4; ++i) { const int ci = i * 512 + tid, row = ci >> 4, ch = ci & 15; *(LAS u32x4*)(TC + row * 136 + 8 * ch) = *(const GAS u32x4*)(WCg + row * 128 + 8 * ch); *(LAS u32x4*)(TS + row * 136 + 8 * ch) = *(const GAS u32x4*)(WSg + row * 128 + 8 * ch); }
        if (tid < 128) { const f32x2 t2 = *(const GAS f32x2*)((const GAS float*)TW + 2 * (s2 * 128 + tid)); TWr[2 * tid] = t2[0]; TWr[2 * tid + 1] = t2[1]; }
#pragma unroll
        for (int ps = 0; ps < 4; ++ps) { const int s1 = ps * 32 + (tid >> 4), ch = tid & 15;
            const u32x4 v = *(const GAS u32x4*)(FUg + (size_t)(128 * s1 + s2) * 256 + half * 128 + 8 * ch);
            LAS bf16_t* dp = UT2 + (8 * ch) * 136 + s1;
            dp[0 * 136] = (bf16_t)(v.x & 0xffffu); dp[1 * 136] = (bf16_t)(v.x >> 16); dp[2 * 136] = (bf16_t)(v.y & 0xffffu); dp[3 * 136] = (bf16_t)(v.y >> 16);
            dp[4 * 136] = (bf16_t)(v.z & 0xffffu); dp[5 * 136] = (bf16_t)(v.z >> 16); dp[6 * 136] = (bf16_t)(v.w & 0xffffu); dp[7 * 136] = (bf16_t)(v.w >> 16); }
        __syncthreads();
        f32x4 re[8], im[8];
#pragma unroll
        for (int mt = 0; mt < 8; ++mt) { re[mt] = (f32x4){0.f, 0.f, 0.f, 0.f}; im[mt] = (f32x4){0.f, 0.f, 0.f, 0.f}; }
#pragma unroll
        for (int kk = 0; kk < 4; ++kk) { const bf16x8 b = *(const LAS bf16x8*)(UT2 + (16 * w + fr) * 136 + 32 * kk + 8 * fq);
#pragma unroll
            for (int mt = 0; mt < 8; ++mt) { const bf16x8 ac = *(const LAS bf16x8*)(TC + (16 * mt + fr) * 136 + 32 * kk + 8 * fq), as = *(const LAS bf16x8*)(TS + (16 * mt + fr) * 136 + 32 * kk + 8 * fq);
                re[mt] = mfma16(ac, b, re[mt]); im[mt] = mfma16(as, b, im[mt]); } }
        __syncthreads();
#pragma unroll
        for (int mt = 0; mt < 8; ++mt)
#pragma unroll
            for (int j = 0; j < 4; ++j) { const int p1 = 16 * mt + 4 * fq + j; const float tw0 = TWr[2 * p1], tw1 = TWr[2 * p1 + 1];
                const float tr = re[mt][j], ti = -im[mt][j]; const float orr = tr * tw0 + ti * tw1, oi = ti * tw0 - tr * tw1;
                OB[p1 * 264 + 16 * w + fr] = f2bf(orr); OB[p1 * 264 + 128 + 16 * w + fr] = f2bf(oi); }
        __syncthreads();
#pragma unroll
        for (int i = 0; i < 8; ++i) { const int ci = i * 512 + tid; const int p1 = ci >> 5, part = (ci >> 4) & 1, ch = ci & 15;
            const u32x4 v = *(const LAS u32x4*)(OB + p1 * 264 + part * 128 + 8 * ch);
            *(GAS u32x4*)((GAS bf16_t*)TP + ((size_t)p1 * 128 + s2) * 512 + part * 256 + half * 128 + 8 * ch) = v; }
        __syncthreads();
    }
}
__device__ __forceinline__ void fft_f3(const Ctx& c, int wid, int nw, const bf16_t* TP, const bf16_t* WC, const bf16_t* WSn, const bf16_t* C64, const bf16_t* S64, bf16_t* MIXED) {
    const int tid = c.tid, lane = c.lane, w = c.wave, fr = lane & 15, fq = lane >> 4;
    LAS bf16_t* TrT = (LAS bf16_t*)c.lds;
    LAS bf16_t* TiT = (LAS bf16_t*)(c.lds + 17408);
    LAS bf16_t* XB = (LAS bf16_t*)(c.lds + 34816 + w * 4352);
    LAS bf16_t* T64 = (LAS bf16_t*)(c.lds + 69632);
    { const int tbl = tid >> 8, r_ = (tid >> 2) & 63, ch = tid & 3; const GAS bf16_t* srcp = (const GAS bf16_t*)(tbl ? S64 : C64) + r_ * 64 + 16 * ch;
        *(LAS u32x4*)(T64 + tbl * 4608 + r_ * 72 + 16 * ch) = *(const GAS u32x4*)srcp; *(LAS u32x4*)(T64 + tbl * 4608 + r_ * 72 + 16 * ch + 8) = *(const GAS u32x4*)(srcp + 8); }
    bf16x8 fac[4], fas[4], fans[4];
#pragma unroll
    for (int kk = 0; kk < 4; ++kk) { fac[kk] = *(const GAS bf16x8*)((const GAS bf16_t*)WC + (16 * w + fr) * 128 + 32 * kk + 8 * fq); fas[kk] = *(const GAS bf16x8*)((const GAS bf16_t*)WSn + (16 * w + fr) * 128 + 32 * kk + 8 * fq);
#pragma unroll
        for (int e = 0; e < 8; ++e) fans[kk][e] = (short)(fas[kk][e] ^ (short)0x8000); }
    u32x4 pr0, pr1, pi0, pi1;
#define F3_LOAD(IT) do { const int p1_ = (IT) >> 2, g_ = (IT) & 3; const GAS bf16_t* src = (const GAS bf16_t*)TP + ((size_t)p1_ * 128 + (tid >> 2)) * 512 + g_ * 64 + 16 * (tid & 3); \
        pr0 = *(const GAS u32x4*)src; pr1 = *(const GAS u32x4*)(src + 8); pi0 = *(const GAS u32x4*)(src + 256); pi1 = *(const GAS u32x4*)(src + 264); } while (0)
    for (int it = wid; it < 512; it += nw) {
        const int p1 = it >> 2, g = it & 3;
        { const int s2 = tid >> 2, ch = tid & 3;
            F3_LOAD(it);
            const u32x4 r0 = pr0, r1 = pr1, i0 = pi0, i1 = pi1;
            LAS bf16_t* dn = TrT + s2 * 136 + 16 * ch;
            *(LAS u32x4*)dn = r0; *(LAS u32x4*)(dn + 8) = r1; *(LAS u32x4*)(dn + 64) = i0; *(LAS u32x4*)(dn + 72) = i1; }
        __syncthreads();
        f32x4 xr[4], xi[4];
#pragma unroll
        for (int nt = 0; nt < 4; ++nt) { xr[nt] = (f32x4){0.f, 0.f, 0.f, 0.f}; xi[nt] = (f32x4){0.f, 0.f, 0.f, 0.f}; }
        const unsigned vbt = (unsigned)(size_t)((LAS unsigned char*)TrT + (8 * fq + (fr >> 2)) * 272 + 8 * (fr & 3));
#define F3_RD(KK, NT, RL, RH, IL, IH) const s16x4 RL = tr_read<(KK) * 8704 + (NT) * 32>(vbt), RH = tr_read<(KK) * 8704 + 1088 + (NT) * 32>(vbt), IL = tr_read<(KK) * 8704 + 128 + (NT) * 32>(vbt), IH = tr_read<(KK) * 8704 + 1088 + 128 + (NT) * 32>(vbt)
#define F3_MM(KK, NT, RL, RH, IL, IH) do { const bf16x8 br = (bf16x8){RL[0], RL[1], RL[2], RL[3], RH[0], RH[1], RH[2], RH[3]}, bi = (bf16x8){IL[0], IL[1], IL[2], IL[3], IH[0], IH[1], IH[2], IH[3]}; \
            xr[NT] = mfma16(fac[KK], br, xr[NT]); xr[NT] = mfma16(fas[KK], bi, xr[NT]); xi[NT] = mfma16(fac[KK], bi, xi[NT]); xi[NT] = mfma16(fans[KK], br, xi[NT]); } while (0)
#define F3_HALF(KK, N0, N1) do { F3_RD(KK, N0, a0, a1, a2, a3); F3_RD(KK, N1, b0, b1, b2, b3); \
            asm volatile("s_waitcnt lgkmcnt(0)" ::: "memory"); __builtin_amdgcn_sched_barrier(0); \
            F3_MM(KK, N0, a0, a1, a2, a3); F3_MM(KK, N1, b0, b1, b2, b3); __builtin_amdgcn_sched_barrier(0); } while (0)
#define F3_KSTEP(KK) do { F3_HALF(KK, 0, 1); F3_HALF(KK, 2, 3); } while (0)
        F3_KSTEP(0); F3_KSTEP(1); F3_KSTEP(2); F3_KSTEP(3);
#undef F3_KSTEP
#undef F3_HALF
#undef F3_MM
#undef F3_RD
#pragma unroll
        for (int nt = 0; nt < 4; ++nt)
#pragma unroll
            for (int j = 0; j < 4; ++j) { XB[(4 * fq + j) * 136 + 16 * nt + fr] = f2bf(xr[nt][j]); XB[(4 * fq + j) * 136 + 64 + 16 * nt + fr] = f2bf(xi[nt][j]); }
        LDS_WAIT();
        f32x4 y[4];
#pragma unroll
        for (int nt = 0; nt < 4; ++nt) y[nt] = (f32x4){0.f, 0.f, 0.f, 0.f};
#pragma unroll
        for (int kk = 0; kk < 4; ++kk) { const bf16x8 a = *(const LAS bf16x8*)(XB + fr * 136 + 32 * kk + 8 * fq); const LAS bf16_t* tb = T64 + ((kk < 2) ? 0 : 4608);
#pragma unroll
            for (int nt = 0; nt < 4; ++nt) { const bf16x8 b = *(const LAS bf16x8*)(tb + (16 * nt + fr) * 72 + 32 * (kk & 1) + 8 * fq); y[nt] = mfma16(a, b, y[nt]); } }
#pragma unroll
        for (int j = 0; j < 4; ++j) { const size_t prow = (size_t)(p1 + 128 * (16 * w + 4 * fq + j));
#pragma unroll
            for (int nt = 0; nt < 4; ++nt) ((GAS bf16_t*)MIXED)[prow * 1024 + 256 + g * 64 + 16 * nt + fr] = f2bf(y[nt][j] * (1.f / 1024.f)); }
        __syncthreads();
    }
}

#define XB_TMO      128
#define XB_XCNT(j)  (256  + 64 * (j))
#define XB_XSUB(j)  (1280 + 64 * (j))
#define XB_XGEN(j)  (2304 + 64 * (j))
#define XB_TOP      3328
#define XB_TOPGEN   3392
#define XCD_BAR_WORDS 3456
#define XB_SPIN_CAP (1u << 18)

__device__ __forceinline__ unsigned xb_ld(unsigned* p)              { return __hip_atomic_load(p, __ATOMIC_RELAXED, __HIP_MEMORY_SCOPE_AGENT); }
__device__ __forceinline__ unsigned xb_add(unsigned* p, unsigned v) { return __hip_atomic_fetch_add(p, v, __ATOMIC_RELAXED, __HIP_MEMORY_SCOPE_AGENT); }
__device__ __forceinline__ unsigned xb_xcc_id() { return (unsigned)__builtin_amdgcn_s_getreg((3 << 11) | 20) & 0xFu; }
#define XB_SPIN(cond, bar) do { unsigned _sp = 0; while (cond) { __builtin_amdgcn_s_sleep(1); \
    if ((++_sp & 255u) == 0u) { if (xb_ld(&(bar)[XB_TMO])) break; if (_sp > XB_SPIN_CAP) { atomicAdd(&(bar)[XB_TMO], 1u); break; } } } } while (0)

struct XcdBarrier {
    unsigned* bar; unsigned x;
    volatile LAS unsigned* st;
};

__device__ __forceinline__ XcdBarrier xcd_barrier_post(unsigned* bar, volatile LAS unsigned* st) {
    XcdBarrier b; b.bar = bar; b.x = xb_xcc_id(); b.st = st;
    if (threadIdx.x == 0) (void)xb_add(&bar[XB_XCNT(b.x)], 1u);
    return b;
}
__device__ __forceinline__ void xcd_barrier_complete(unsigned* bar, unsigned x, unsigned& nloc, unsigned& nx) {
    const unsigned G = gridDim.x * gridDim.y * gridDim.z;
    unsigned sum, cnt, mine, sp = 0u;
    for (;;) {
        sum = 0u; cnt = 0u; mine = 0u;
#pragma unroll
        for (unsigned j = 0; j < 16; ++j) { const unsigned c = xb_ld(&bar[XB_XCNT(j)]); sum += c; cnt += (c > 0u) ? 1u : 0u; mine = (j == x) ? c : mine; }
        if (sum == G) break;
        __builtin_amdgcn_s_sleep(1);
        if ((++sp & 255u) == 0u) { if (xb_ld(&bar[XB_TMO])) break; if (sp > XB_SPIN_CAP) { atomicAdd(&bar[XB_TMO], 1u); break; } }
    }
    nloc = mine > 0u ? mine : 1u; nx = cnt > 0u ? cnt : 1u;
}

__device__ __forceinline__ void xcd_barrier(const XcdBarrier& b) {
    asm volatile("s_waitcnt vmcnt(0)" ::: "memory");
    __syncthreads();
    if (threadIdx.x == 0) {
        unsigned* bar = b.bar;
        __builtin_amdgcn_s_waitcnt(0);
        unsigned nloc = b.st[0], nx = b.st[1];
        if (nloc == 0u) { xcd_barrier_complete(bar, b.x, nloc, nx); b.st[0] = nloc; b.st[1] = nx; }
        const unsigned old = xb_add(&bar[XB_XSUB(b.x)], 1u);
        const unsigned gen = old / nloc;
        if (old + 1u == (gen + 1u) * nloc) {
            __builtin_amdgcn_fence(__ATOMIC_RELEASE, "agent");
            asm volatile("s_waitcnt vmcnt(0)" ::: "memory");
            const unsigned og = xb_add(&bar[XB_TOP], 1u);
            const unsigned tg = og / nx;
            if (og + 1u == (tg + 1u) * nx) xb_add(&bar[XB_TOPGEN], 1u);
            else XB_SPIN(xb_ld(&bar[XB_TOPGEN]) == tg, bar);
            __builtin_amdgcn_fence(__ATOMIC_ACQUIRE, "agent");
            xb_add(&bar[XB_XGEN(b.x)], 1u);
            asm volatile("s_waitcnt vmcnt(0)" ::: "memory");
        } else {
            XB_SPIN(xb_ld(&bar[XB_XGEN(b.x)]) == gen, bar);
            __builtin_amdgcn_fence(__ATOMIC_ACQUIRE, "agent");
            asm volatile("s_waitcnt vmcnt(0)" ::: "memory");
        }
    }
    __syncthreads();
}

typedef const __attribute__((address_space(4))) P* kargp;
__device__ __forceinline__ P ldP(kargp q) { P r; r.x = q->x; r.pos = q->pos; r.anw = q->anw; r.w_in = q->w_in; r.lbs = q->lbs; r.w_out = q->w_out; r.mnw = q->mnw; r.w_up = q->w_up; r.w_down = q->w_down; r.fnw = q->fnw;
    r.out = q->out; r.ws = q->ws; r.ph_lo = q->ph_lo; r.ph_hi = q->ph_hi; r.dup = q->dup; r.pad = q->pad; return r; }
constexpr int PH_PER_LAYER = 7, N_PHASES = DEPTH * PH_PER_LAYER + 2;
__global__ void __launch_bounds__(NTHR, 2) mega(P p_unused) {
    const kargp pk0 = (kargp)__builtin_amdgcn_kernarg_segment_ptr();
#define PL() ({ kargp q_ = pk0; asm volatile("" : "+s"(q_)); ldP(q_); })
    const int ph_lo = pk0->ph_lo, ph_hi = pk0->ph_hi, dupm = pk0->dup, padv = pk0->pad;
    unsigned char* const ws_base = pk0->ws;
    extern __shared__ __attribute__((aligned(16))) unsigned char lds_raw[];
    cg::grid_group grid = cg::this_grid();
#define WSL unsigned char* ws = ws_base; asm volatile("" : "+s"(ws))
    { volatile LAS unsigned* st0 = (volatile LAS unsigned*)((LAS unsigned char*)lds_raw + LDS_ST_OFF); if (threadIdx.x < 2) st0[threadIdx.x] = 0u; }
    __syncthreads();
    const XcdBarrier xbar = xcd_barrier_post((unsigned*)(ws_base + OFF_BAR), (volatile LAS unsigned*)((LAS unsigned char*)lds_raw + LDS_ST_OFF));
    for (int gp = ph_lo; gp < ph_hi; ++gp) {
        const int layer = (gp - 1) / PH_PER_LAYER, ph = (gp - 1) % PH_PER_LAYER;
        const int reps = (gp != 0 && gp != N_PHASES - 1 && ((dupm >> ph) & 1)) ? 2 : 1;
        for (int rep = 0; rep < reps; ++rep) {
        Ctx c; c.lds = (LAS unsigned char*)lds_raw; { int t_ = threadIdx.x; asm volatile("" : "+v"(t_)); c.tid = t_; } c.lane = c.tid & 63; c.wave = __builtin_amdgcn_readfirstlane(c.tid >> 6); c.bid = blockIdx.x; c.G = gridDim.x;
        if (gp == N_PHASES - 1) {
            { WSL; final_norm(c, (const bf16_t*)(ws + WS_XN), (const float*)(ws + OFF_SSQA), PL().fnw, PL().out); }
        } else if (gp == 0) {
            { const P pl = PL(); make_tables(c, pl); convert_weights(c, pl, 1, 0, 0, c.bid * 8 + c.wave, c.G * 8); }
            WSL;
            x_to_bf16_ssq(c, PL().x, (bf16_t*)(ws + WS_XN), (float*)(ws + OFF_SSQA));
        } else if (ph == 0) {
            WSL;
            pg8::Gemm g{(const bf16_t*)(ws + WS_XN), (const bf16_t*)(ws + W_IN), S, NIN, D}; pg8::StaticOrder so; so.init(S, NIN, c.G, c.bid);
            EpiIn E{(bf16_t*)(ws + WS_HQ), (bf16_t*)(ws + WS_HV), (bf16_t*)(ws + WS_HG), (bf16_t*)(ws + WS_FU), (bf16_t*)(ws + WS_AQ), (bf16_t*)(ws + WS_AK), (bf16_t*)(ws + WS_AV), (_Float16*)(ws + WS_LF),
                    (const float*)(ws + OFF_LB) + layer * 512, (const float*)(ws + OFF_CS), (const float*)(ws + OFF_SSQA), c.lds, 0};
            { pg8::Unit u0; u0.pm = 0; u0.pn = 0; so.next(0, u0); E.pm0 = u0.pm; fill_rs_table(c.lds, E.ssq, E.pm0, c.tid); }
            pg8::gemm_phase<EpiIn, pg8::StaticOrder, false>(c.lds, g, so, E, nullptr);
        } else if (ph == 1) {
            for (int r2 = 0; r2 < 1 + ((dupm >> 8) & 1); ++r2) { WSL; hgrn_passA(c, (const _Float16*)(ws + WS_LF), (const bf16_t*)(ws + WS_HV), PL().out  , (float*)(ws + WS_DEC)); }
            for (int r2 = 0; r2 < 1 + ((dupm >> 9) & 1); ++r2) { WSL; attn_phase(c, (const bf16_t*)(ws + WS_AQ), (const bf16_t*)(ws + WS_AK), (const bf16_t*)(ws + WS_AV), (bf16_t*)(ws + WS_OP), (float*)(ws + WS_LSE)); }
            for (int r2 = 0; r2 < 1 + ((dupm >> 10) & 1); ++r2) { WSL; fft_f1(c, (const bf16_t*)(ws + WS_FU), (const bf16_t*)(ws + OFF_W128C), (const bf16_t*)(ws + OFF_W128S), (const float*)(ws + OFF_TW), (bf16_t*)(ws + WS_TP)); }
        } else if (ph == 2) {
            WSL;
            const float* UT = (const float*)PL().out; const float* DEC = (const float*)(ws + WS_DEC); bf16_t* SS = (bf16_t*)(ws + WS_SS);
            const int nscan = (c.G >= 128) ? 64 : 0;
            if (c.bid < nscan) { for (int sb = c.bid; sb < 64; sb += nscan) hgrn_scan(sb, c.tid, UT, DEC, SS); }
            fft_f3(c, c.bid, c.G, (const bf16_t*)(ws + WS_TP), (const bf16_t*)(ws + OFF_W128C), (const bf16_t*)(ws + OFF_W128S), (const bf16_t*)(ws + OFF_C64), (const bf16_t*)(ws + OFF_S64), (bf16_t*)(ws + WS_MIXED));
            if (c.bid >= nscan) { if (nscan == 0) { for (int sb = c.bid; sb < 64; sb += c.G) hgrn_scan(sb, c.tid, UT, DEC, SS); }
                const int wid = c.bid - nscan, nw = c.G - nscan;
                attn_combine((const bf16_t*)(ws + WS_OP), (const float*)(ws + WS_LSE), (bf16_t*)(ws + WS_MIXED), 0, S * 64, wid, nw, c.tid);
                __syncthreads();
                { const P pl = PL(); convert_weights(c, pl, (layer + 1 < DEPTH) ? 3 : 2, layer + 1, layer, wid * 8 + c.wave, nw * 8); } }
        } else if (ph == 3) {
            WSL;
            hgrn_passC(c, (const _Float16*)(ws + WS_LF), (const bf16_t*)(ws + WS_HQ), (const bf16_t*)(ws + WS_HV), (const bf16_t*)(ws + WS_HG), (const bf16_t*)(ws + WS_SS), (bf16_t*)(ws + WS_MIXED));
        } else if (ph == 4) {
            WSL;
            pg8::Gemm g{(const bf16_t*)(ws + WS_MIXED), (const bf16_t*)(ws + W_OUT), S, D, D}; pg8::StaticOrder so; so.init(S, D, c.G, c.bid);
            EpiRes E{(bf16_t*)(ws + WS_XN), (float*)(ws + OFF_SSQM), D, nullptr, c.lds, 0};
            pg8::gemm_phase<EpiRes, pg8::StaticOrder, false>(c.lds, g, so, E, nullptr);
        } else if (ph == 5) {
            WSL;
            pg8::Gemm g{(const bf16_t*)(ws + WS_XN), (const bf16_t*)(ws + W_UP), S, FF, D}; pg8::StaticOrder so; so.init(S, FF, c.G, c.bid);
            EpiUp E{(bf16_t*)(ws + WS_H), FF};
            pg8::gemm_phase<EpiUp, pg8::StaticOrder, false>(c.lds, g, so, E, nullptr);
        } else {
            WSL;
            pg8::Gemm g{(const bf16_t*)(ws + WS_H), (const bf16_t*)(ws + W_DOWN), S, D, FF}; pg8::StaticOrder so; so.init(S, D, c.G, c.bid);
            EpiRes E{(bf16_t*)(ws + WS_XN), (float*)(ws + OFF_SSQA), D, (const float*)(ws + OFF_SSQM), c.lds, 0};
            { pg8::Unit u0; u0.pm = 0; u0.pn = 0; so.next(0, u0); E.pm0 = u0.pm; fill_rs_table(c.lds, E.ssq_in, E.pm0, c.tid); }
            pg8::gemm_phase<EpiRes, pg8::StaticOrder, false>(c.lds, g, so, E, nullptr);
        }
        if (reps > 1) __syncthreads();
        }
        if (gp + 1 < ph_hi) { if (padv == 0x7fffffff) grid.sync(); xcd_barrier(xbar); if (padv) { xcd_barrier(xbar); xcd_barrier(xbar); } }
    }
}
}

extern "C" void kernel_launch(void* const* d_in, const int* in_sizes, int n_in, void* d_out, int out_size, void* d_ws, size_t ws_size, hipStream_t stream) {
    static int grid = 0;
    if (grid == 0) {
        int dev = 0, cus = 0, per_cu = 0;
        hipGetDevice(&dev);
        hipDeviceGetAttribute(&cus, hipDeviceAttributeMultiprocessorCount, dev);
        if (hipFuncSetAttribute((const void*)mk::mega, hipFuncAttributeMaxDynamicSharedMemorySize, mk::LDS_BYTES) != hipSuccess) fprintf(stderr, "kernel_launch: hipFuncSetAttribute failed\n");
        if (hipOccupancyMaxActiveBlocksPerMultiprocessor(&per_cu, (const void*)mk::mega, mk::NTHR, mk::LDS_BYTES) != hipSuccess || per_cu < 1) { fprintf(stderr, "kernel_launch: occupancy query says %d\n", per_cu); per_cu = 1; }
        (void)hipGetLastError();
        grid = cus * per_cu; if (grid > 256) grid = 256; if (grid < 1) grid = 256;
    }
    mk::P p{};
    p.x = (const float*)d_in[0]; p.pos = (const int*)d_in[1]; p.anw = (const float*)d_in[2]; p.w_in = (const float*)d_in[3]; p.lbs = (const float*)d_in[4]; p.w_out = (const float*)d_in[5];
    p.mnw = (const float*)d_in[6]; p.w_up = (const float*)d_in[7]; p.w_down = (const float*)d_in[8]; p.fnw = (const float*)d_in[9]; p.out = (float*)d_out; p.ws = (unsigned char*)d_ws;
    p.ph_lo = 0; p.ph_hi = mk::N_PHASES;
#ifdef DUP_MASK
    p.dup = DUP_MASK;
#endif
#ifdef DUP_SYNC
    p.pad = 1;
#endif
    (void)hipMemsetAsync((unsigned char*)d_ws + mk::OFF_BAR, 0, mk::BAR_BYTES, stream);
    void* args[] = {&p};
    hipError_t e = hipLaunchCooperativeKernel((const void*)mk::mega, dim3(grid), dim3(mk::NTHR), args, mk::LDS_BYTES, stream);
    if (e != hipSuccess) fprintf(stderr, "kernel_launch: cooperative launch failed: %s (grid %d)\n", hipGetErrorString(e), grid);
}
```
